# Optimizing an MI355X kernel written in HIP

```python
import math
import jax, jax.numpy as jnp
from jax import lax
import numpy as np

D_MODEL = 1024
BATCH = 32
SEQ = 2048
DEPTH = 4

GRID_W = 64
CTX_LEN = 256
EPS = 1e-6
D_FF = 4 * D_MODEL
D_FOURIER = D_MODEL // 2
FOURIER_GROUPS = 4
FOURIER_CH = D_FOURIER // FOURIER_GROUPS
D_SSM = D_MODEL - D_FOURIER
SSM_GROUP = 16
SSM_GROUPS = D_SSM // SSM_GROUP
SSM_STATE = 64
DT_MIN = 0.001
DT_MAX = 0.1
DA_HEAD_DIM = 64
DA_V_DIM = 2 * DA_HEAD_DIM
DA_HEADS = D_MODEL // DA_V_DIM
ROPE_THETA = 10000.0
Q_BLOCK = 128
N_EVEN = (DEPTH + 1) // 2
N_ODD = DEPTH // 2

kernel_name = "hybrid_fourier_s5_diffattn_prefix_dit"

F32 = jnp.float32


def rmsnorm(x, g):
    xf = x.astype(F32)
    y = xf * lax.rsqrt(jnp.mean(xf * xf, axis=-1, keepdims=True) + EPS)
    return (y * g.astype(F32)).astype(x.dtype)


def modulate(h, shift, scale):
    return h * (1.0 + scale) + shift


def adaln(cond, w, b):
    m = jax.nn.silu(cond) @ w + b
    return jnp.split(m[..., None, :], 6, axis=-1)


def sq_relu_mlp(h, w1, w2):
    return jnp.square(jax.nn.relu(h @ w1)) @ w2


def axial_rope_angles(rows):
    row = jnp.repeat(jnp.arange(rows, dtype=F32), GRID_W)
    col = jnp.tile(jnp.arange(GRID_W, dtype=F32), rows)
    half = DA_HEAD_DIM // 2
    inv_freq = ROPE_THETA ** (-jnp.arange(0, half, 2, dtype=F32) / half)
    ang_row = (row[:, None] * inv_freq)[:, None, None, :]
    ang_col = (col[:, None] * inv_freq)[:, None, None, :]
    return ang_row, ang_col


def rope_axis(x, ang):
    x1, x2 = jnp.split(x, 2, axis=-1)
    cos, sin = jnp.cos(ang), jnp.sin(ang)
    return jnp.concatenate([x1 * cos - x2 * sin, x1 * sin + x2 * cos], axis=-1).astype(x.dtype)


def apply_axial_rope(x, ang_row, ang_col):
    half = DA_HEAD_DIM // 2
    return jnp.concatenate([rope_axis(x[..., :half], ang_row), rope_axis(x[..., half:], ang_col)], axis=-1)


def fourier_mix(u):
    bsz, l, _ = u.shape
    ug = u.astype(F32).reshape(bsz, l, FOURIER_GROUPS, FOURIER_CH)
    y = jnp.fft.fft2(ug, axes=(1, 3), norm="ortho").real
    return y.reshape(bsz, l, D_FOURIER).astype(u.dtype)


def _linear_recurrence(e1, e2):
    a1, b1 = e1
    a2, b2 = e2
    return a1 * a2, a2 * b1 + b2


def s5_scan(u, a_re, a_im, log_dt, b_re, b_im, h0s):
    bsz, l, _ = u.shape
    ug = u.astype(F32).reshape(bsz, l, SSM_GROUPS, SSM_GROUP)
    states, finals = [], []
    for d in range(2):
        a = lax.complex(a_re[d].astype(F32), a_im[d].astype(F32))
        dt = jnp.exp(log_dt[d].astype(F32))[:, None]
        a_bar = jnp.exp(a * dt)
        b_c = lax.complex(b_re[d].astype(F32), b_im[d].astype(F32))
        b_bar = ((a_bar - 1.0) / a)[..., None] * b_c
        bu = jnp.einsum("blgh,gph->blgp", ug, b_bar)
        reverse = d == 1
        if h0s is not None:
            edge = -1 if reverse else 0
            bu = bu.at[:, edge].add(a_bar * h0s[d])
        h = lax.associative_scan(_linear_recurrence, (jnp.broadcast_to(a_bar, bu.shape), bu),
                                 axis=1, reverse=reverse)[1]
        states.append(h)
        finals.append(h[:, 0] if reverse else h[:, -1])
    return states, finals


def s5_readout(u, states, c_re, c_im, d_skip, w_glu, b_glu):
    bsz, l, _ = u.shape
    y = u.astype(F32) * d_skip.astype(F32)
    for d in range(2):
        cc = lax.complex(c_re[d].astype(F32), c_im[d].astype(F32))
        y = y + jnp.einsum("blgp,ghp->blgh", states[d], cc).real.reshape(bsz, l, D_SSM)
    y = jax.nn.gelu(y).astype(u.dtype)
    return y * jax.nn.sigmoid(y @ w_glu + b_glu)


def even_out(z, states, c_re, c_im, d_skip, w_glu, b_glu, w_out):
    ya = fourier_mix(z[..., :D_FOURIER])
    yb = s5_readout(z[..., D_FOURIER:], states, c_re, c_im, d_skip, w_glu, b_glu)
    return jnp.concatenate([ya, yb], axis=-1) @ w_out


def diff_qkv(h, w_in, gq, gk, ang):
    bsz, l, _ = h.shape
    q, k, v = jnp.split(h @ w_in, 3, axis=-1)
    q = rmsnorm(q.reshape(bsz, l, DA_HEADS, 2, DA_HEAD_DIM), gq)
    k = rmsnorm(k.reshape(bsz, l, DA_HEADS, 2, DA_HEAD_DIM), gk)
    v = v.reshape(bsz, l, DA_HEADS, DA_V_DIM)
    if ang is not None:
        q = apply_axial_rope(q, *ang)
        k = apply_axial_rope(k, *ang)
    return q, k, v


def diff_attend(q, k, v, lam):
    s = jnp.einsum("bqhmd,bkhmd->bhmqk", q, k).astype(F32) * (DA_HEAD_DIM ** -0.5)
    p = jax.nn.softmax(s, axis=-1)
    w = (p[:, :, 0] - lam * p[:, :, 1]).astype(v.dtype)
    return jnp.einsum("bhqk,bkhd->bqhd", w, v)


def blocked_diff_attention(q, k, v, lam):
    bsz, l = q.shape[:2]
    nb = l // Q_BLOCK
    qb = jnp.moveaxis(q.reshape(bsz, nb, Q_BLOCK, DA_HEADS, 2, DA_HEAD_DIM), 1, 0)
    ob = lax.map(lambda qi: diff_attend(qi, k, v, lam), qb)
    return jnp.moveaxis(ob, 0, 1).reshape(bsz, l, DA_HEADS, DA_V_DIM)


def diff_out(o, g_head, lam_init, w_out):
    bsz, l = o.shape[:2]
    o = rmsnorm(o, g_head) * (1.0 - lam_init)
    return o.reshape(bsz, l, DA_HEADS * DA_V_DIM) @ w_out


def setup_inputs(seed: int = 0) -> dict:
    key = jax.random.key(seed)
    keys = iter(jax.random.split(key, 40))

    def normal(shape, scale):
        return jax.random.normal(next(keys), shape, F32) * scale

    a_im_base = jnp.pi * jnp.arange(SSM_STATE, dtype=F32)
    return {
        "x": normal((BATCH, SEQ, D_MODEL), 1.0),
        "c": normal((BATCH, D_MODEL), 1.0),
        "ctx": normal((BATCH, CTX_LEN, D_MODEL), 1.0),
        "c_ctx": normal((D_MODEL,), 1.0),
        "norm1_g": 1.0 + normal((DEPTH, D_MODEL), 0.01),
        "norm2_g": 1.0 + normal((DEPTH, D_MODEL), 0.01),
        "ada_w": normal((DEPTH, D_MODEL, 6 * D_MODEL), 0.5 * D_MODEL ** -0.5),
        "ada_b": normal((DEPTH, 6 * D_MODEL), 0.01),
        "mlp_w1": normal((DEPTH, D_MODEL, D_FF), D_MODEL ** -0.5),
        "mlp_w2": normal((DEPTH, D_FF, D_MODEL), D_FF ** -0.5),
        "ev_w_in": normal((N_EVEN, D_MODEL, D_FOURIER + D_SSM), D_MODEL ** -0.5),
        "ev_w_out": normal((N_EVEN, D_FOURIER + D_SSM, D_MODEL), (D_FOURIER + D_SSM) ** -0.5),
        "ssm_a_re": -0.5 + normal((N_EVEN, 2, SSM_GROUPS, SSM_STATE), 0.01),
        "ssm_a_im": a_im_base + normal((N_EVEN, 2, SSM_GROUPS, SSM_STATE), 0.01),
        "ssm_log_dt": jax.random.uniform(next(keys), (N_EVEN, 2, SSM_GROUPS), F32,
                                         minval=math.log(DT_MIN), maxval=math.log(DT_MAX)),
        "ssm_b_re": normal((N_EVEN, 2, SSM_GROUPS, SSM_STATE, SSM_GROUP), (2 * SSM_GROUP) ** -0.5),
        "ssm_b_im": normal((N_EVEN, 2, SSM_GROUPS, SSM_STATE, SSM_GROUP), (2 * SSM_GROUP) ** -0.5),
        "ssm_c_re": normal((N_EVEN, 2, SSM_GROUPS, SSM_GROUP, SSM_STATE), (2 * SSM_STATE) ** -0.5),
        "ssm_c_im": normal((N_EVEN, 2, SSM_GROUPS, SSM_GROUP, SSM_STATE), (2 * SSM_STATE) ** -0.5),
        "ssm_d": normal((N_EVEN, D_SSM), 1.0),
        "ssm_w_glu": normal((N_EVEN, D_SSM, D_SSM), D_SSM ** -0.5),
        "ssm_b_glu": normal((N_EVEN, D_SSM), 0.01),
        "od_w_in": normal((N_ODD, D_MODEL, 3 * D_MODEL), D_MODEL ** -0.5),
        "od_w_out": normal((N_ODD, D_MODEL, D_MODEL), D_MODEL ** -0.5),
        "od_q_norm": 1.0 + normal((N_ODD, DA_HEAD_DIM), 0.01),
        "od_k_norm": 1.0 + normal((N_ODD, DA_HEAD_DIM), 0.01),
        "od_lambda": normal((N_ODD, 4, DA_HEAD_DIM), 0.1),
        "od_head_norm": 1.0 + normal((N_ODD, DA_V_DIM), 0.01),
    }


def reference(x, c, ctx, c_ctx, norm1_g, norm2_g, ada_w, ada_b, mlp_w1, mlp_w2,
              ev_w_in, ev_w_out, ssm_a_re, ssm_a_im, ssm_log_dt, ssm_b_re, ssm_b_im,
              ssm_c_re, ssm_c_im, ssm_d, ssm_w_glu, ssm_b_glu,
              od_w_in, od_w_out, od_q_norm, od_k_norm, od_lambda, od_head_norm):
    rows = x.shape[1] // GRID_W
    ang = axial_rope_angles(rows)
    for i in range(DEPTH):
        last = i == DEPTH - 1
        j = i // 2
        sh1, sc1, g1, sh2, sc2, g2 = adaln(c, ada_w[i], ada_b[i])
        csh1, csc1, cg1, csh2, csc2, cg2 = adaln(c_ctx, ada_w[i], ada_b[i])
        hx = modulate(rmsnorm(x, norm1_g[i]), sh1, sc1)
        hc = modulate(rmsnorm(ctx, norm1_g[i]), csh1, csc1)
        if i % 2 == 0:
            scan_p = (ssm_a_re[j], ssm_a_im[j], ssm_log_dt[j], ssm_b_re[j], ssm_b_im[j])
            read_p = (ssm_c_re[j], ssm_c_im[j], ssm_d[j], ssm_w_glu[j], ssm_b_glu[j], ev_w_out[j])
            zc = hc @ ev_w_in[j]
            zx = hx @ ev_w_in[j]
            st_c, fin_c = s5_scan(zc[..., D_FOURIER:], *scan_p, None)
            st_x, _ = s5_scan(zx[..., D_FOURIER:], *scan_p, fin_c)
            yx = even_out(zx, st_x, *read_p)
            yc = None if last else even_out(zc, st_c, *read_p)
        else:
            lam_init = 0.8 - 0.6 * math.exp(-0.3 * i)
            lp = od_lambda[j].astype(F32)
            lam = jnp.exp(jnp.sum(lp[0] * lp[1])) - jnp.exp(jnp.sum(lp[2] * lp[3])) + lam_init
            qx, kx, vx = diff_qkv(hx, od_w_in[j], od_q_norm[j], od_k_norm[j], ang)
            qc, kc, vc = diff_qkv(hc, od_w_in[j], od_q_norm[j], od_k_norm[j], None)
            k_all = jnp.concatenate([kx, kc], axis=1)
            v_all = jnp.concatenate([vx, vc], axis=1)
            ox = blocked_diff_attention(qx, k_all, v_all, lam)
            yx = diff_out(ox, od_head_norm[j], lam_init, od_w_out[j])
            yc = None if last else diff_out(diff_attend(qc, kc, vc, lam), od_head_norm[j], lam_init, od_w_out[j])
        x = x + g1 * yx
        x = x + g2 * sq_relu_mlp(modulate(rmsnorm(x, norm2_g[i]), sh2, sc2), mlp_w1[i], mlp_w2[i])
        if not last:
            ctx = ctx + cg1 * yc
            ctx = ctx + cg2 * sq_relu_mlp(modulate(rmsnorm(ctx, norm2_g[i]), csh2, csc2), mlp_w1[i], mlp_w2[i])
    return x
```

```cpp
#include <hip/hip_runtime.h>
#include <hip/hip_bf16.h>
#include <hip/hip_cooperative_groups.h>
#include <cstdio>
namespace cg = cooperative_groups;

#define DI __device__ __forceinline__
typedef unsigned short u16;
using bf16x8 = __attribute__((ext_vector_type(8))) short;
using s16x4 = __attribute__((ext_vector_type(4))) short;
using f32x4 = __attribute__((ext_vector_type(4))) float;
using f32x16 = __attribute__((ext_vector_type(16))) float;
typedef __bf16 bf16x2_t __attribute__((ext_vector_type(2)));
typedef float f32x2_t __attribute__((ext_vector_type(2)));

DI unsigned pack2(float a, float b) {
  f32x2_t v = {a, b};
  bf16x2_t r = __builtin_convertvector(v, bf16x2_t);
  return __builtin_bit_cast(unsigned, r);
}
DI float bflo(unsigned u) { return __uint_as_float(u << 16); }
DI float bfhi(unsigned u) { return __uint_as_float(u & 0xffff0000u); }
DI u16 f2bf(float x) { return (u16)(pack2(x, 0.f) & 0xffffu); }
DI float shx(float v, int o, int lane) { return __int_as_float(__builtin_amdgcn_ds_bpermute((lane ^ o) << 2, __float_as_int(v))); }
DI float wave_sum(float v, int lane) {
#pragma unroll
  for (int o = 32; o >= 1; o >>= 1) v += shx(v, o, lane);
  return v;
}

DI const char* uptr(const void* p) {
  unsigned long long v = (unsigned long long)p;
  unsigned lo = __builtin_amdgcn_readfirstlane((unsigned)v), hi = __builtin_amdgcn_readfirstlane((unsigned)(v >> 32));
  return (const char*)(((unsigned long long)hi << 32) | lo);
}
DI int ltid(int wv) { int l; asm volatile("v_mbcnt_lo_u32_b32 %0, -1, 0\n\tv_mbcnt_hi_u32_b32 %0, -1, %0" : "=v"(l)); return wv * 64 + l; }

constexpr int NX = 65536;
constexpr int NC = 8192;
constexpr int NT = NX + NC;
constexpr size_t MiB = 1ull << 20;
constexpr size_t OFF_W1T = 0, OFF_W2T = 32 * MiB, OFF_EVIN = 64 * MiB, OFF_EVOUT = 70 * MiB, OFF_GLU = 74 * MiB,
                 OFF_ODIN = 75 * MiB, OFF_ODOUT = 87 * MiB, OFF_F2048 = 91 * MiB, OFF_F256 = 107 * MiB,
                 OFF_MODV = 108 * MiB, OFF_BAR = 111 * MiB + 512 * 1024, OFF_CTXR = 112 * MiB, OFF_H = 144 * MiB, OFF_R = 288 * MiB,
                 OFF_STATS = 864 * MiB, OFF_SHW = 869 * MiB, OFF_SH = 874 * MiB, WS_END = 878 * MiB;
constexpr size_t R_ABT = OFF_R, R_ABTC = OFF_R + 128 * MiB, R_ZS = OFF_R + 144 * MiB, R_R0 = OFF_R + 216 * MiB,
                 R_R1 = OFF_R + 288 * MiB, R_YS = OFF_R + 360 * MiB, R_MIX = OFF_R + 432 * MiB;
constexpr size_t R_QKB = OFF_R, R_VT = OFF_R + 288 * MiB, R_HID = OFF_R;
constexpr int LDS_BYTES = 131072;

struct Params {
  const float* in[28];
  float* out;
  unsigned char* ws;
};

constexpr int BM = 256, BK = 64, HALF = 128, HT = HALF * BK;
enum { EPI_STORE = 0, EPI_SQRELU = 1, EPI_RESID = 2, EPI_GLU = 3, EPI_FOUT = 4, EPI_TRANS_F = 5, EPI_TRANS_V = 6, EPI_F32 = 7, EPI_FT = 8, EPI_VT = 9 };

struct Epi {
  u16* o16;
  u16* o16b;
  const u16* a16;
  float* xo;
  float* co;
  const float* xi;
  const float* ci;
  const float* gate;
  const float* bias;
  int ldo;
  int rowbase;
  int L;
  const float* stats;
  const float* shw;
  u16* hout;
  float* stats_out;
  const float* ngain;
  const float* nscale;
};
DI float row_rinv(const float* stats, int r) {
  const float ssum = (stats[r] + stats[NT + r]) + (stats[2 * NT + r] + stats[3 * NT + r]);
  return rsqrtf(ssum * (1.f / 1024.f) + 1e-6f);
}
DI f32x4 row_rinv4(const float* stats, int r) {
  float4 a = *(const float4*)(stats + r), b = *(const float4*)(stats + NT + r), c = *(const float4*)(stats + 2 * NT + r), d = *(const float4*)(stats + 3 * NT + r);
  f32x4 o;
  o[0] = rsqrtf(((a.x + b.x) + (c.x + d.x)) * (1.f / 1024.f) + 1e-6f); o[1] = rsqrtf(((a.y + b.y) + (c.y + d.y)) * (1.f / 1024.f) + 1e-6f);
  o[2] = rsqrtf(((a.z + b.z) + (c.z + d.z)) * (1.f / 1024.f) + 1e-6f); o[3] = rsqrtf(((a.w + b.w) + (c.w + d.w)) * (1.f / 1024.f) + 1e-6f);
  return o;
}

DI int lds_byte(int r, int c) {
  int st = (r >> 4) * 2 + (c >> 5), rr = r & 15, cc = c & 31, ob = rr * 64 + cc * 2;
  return st * 1024 + (ob ^ (((ob >> 9) & 1) << 5));
}
DI void stage_rc(int b, int& R, int& C) {
  int st = b / 1024, sb = b % 1024, swz = sb ^ (((sb >> 9) & 1) << 5);
  R = (st >> 1) * 16 + swz / 64; C = (st & 1) * 32 + (swz % 64) / 2;
}

template <int EPI>
DI void epi4(const Epi& e, int r, int c, f32x4 v, f32x4 rinv4, float shv) {
  if constexpr (EPI == EPI_TRANS_F || EPI == EPI_TRANS_V) {
    if (e.stats) { v[0] = v[0] * rinv4[0] + shv; v[1] = v[1] * rinv4[1] + shv; v[2] = v[2] * rinv4[2] + shv; v[3] = v[3] * rinv4[3] + shv; }
  }
  if constexpr (EPI == EPI_STORE) {
    uint2 o; o.x = pack2(v[0], v[1]); o.y = pack2(v[2], v[3]);
    *(uint2*)(e.o16 + (size_t)r * e.ldo + c) = o;
  } else if constexpr (EPI == EPI_SQRELU) {
    float a0 = fmaxf(v[0], 0.f), a1 = fmaxf(v[1], 0.f), a2 = fmaxf(v[2], 0.f), a3 = fmaxf(v[3], 0.f);
    uint2 o; o.x = pack2(a0 * a0, a1 * a1); o.y = pack2(a2 * a2, a3 * a3);
    *(uint2*)(e.o16 + (size_t)r * e.ldo + c) = o;
  } else if constexpr (EPI == EPI_RESID) {
    const float* src; float* dst; int mrow;
    if (r < NX) { src = e.xi + (size_t)r * 1024 + c; dst = e.xo + (size_t)r * 1024 + c; mrow = r >> 11; }
    else { int rc = r - NX; src = e.ci + (size_t)rc * 1024 + c; dst = e.co + (size_t)rc * 1024 + c; mrow = 32; }
    float4 g = *(const float4*)(e.gate + (size_t)mrow * 6144 + c);
    float4 s = *(const float4*)src;
    float4 o; o.x = s.x + g.x * v[0]; o.y = s.y + g.y * v[1]; o.z = s.z + g.z * v[2]; o.w = s.w + g.w * v[3];
    *(float4*)dst = o;
  } else if constexpr (EPI == EPI_GLU) {
    uint2 y = *(const uint2*)(e.a16 + (size_t)r * 512 + c);
    float4 b = *(const float4*)(e.bias + c);
    float y0 = bflo(y.x), y1 = bfhi(y.x), y2 = bflo(y.y), y3 = bfhi(y.y);
    float s0 = 1.f / (1.f + __expf(-(v[0] + b.x))), s1 = 1.f / (1.f + __expf(-(v[1] + b.y)));
    float s2 = 1.f / (1.f + __expf(-(v[2] + b.z))), s3 = 1.f / (1.f + __expf(-(v[3] + b.w)));
    uint2 o; o.x = pack2(y0 * s0, y1 * s1); o.y = pack2(y2 * s2, y3 * s3);
    *(uint2*)(e.o16 + (size_t)r * 1024 + 512 + c) = o;
  } else if constexpr (EPI == EPI_FOUT) {
    int b = c >> 9, cc = c & 511;
    uint2 o; o.x = pack2(v[0], v[1]); o.y = pack2(v[2], v[3]);
    *(uint2*)(e.o16 + ((size_t)e.rowbase + (size_t)b * e.L + r) * 1024 + cc) = o;
  } else if constexpr (EPI == EPI_TRANS_F) {
    int part = c >> 9, jj = c & 511;
    uint2 o; o.x = pack2(v[0], v[1]); o.y = pack2(v[2], v[3]);
    if (r < NX) { int b = r >> 11, l = r & 2047; *(uint2*)(e.o16 + ((size_t)(b * 512 + jj)) * 4096 + part * 2048 + l) = o; }
    else { int rc = r - NX; int b = rc >> 8, l = rc & 255; *(uint2*)(e.o16b + ((size_t)(b * 512 + jj)) * 512 + part * 256 + l) = o; }
  } else if constexpr (EPI == EPI_TRANS_V) {
    uint2 o; o.x = pack2(v[0], v[1]); o.y = pack2(v[2], v[3]);
    int b, pos;
    if (r < NX) { b = r >> 11; pos = r & 2047; } else { int rc = r - NX; b = rc >> 8; pos = 2048 + (rc & 255); }
    pos = (pos & ~12) | ((pos & 4) << 1) | ((pos & 8) >> 1);
    *(uint2*)(e.o16 + ((size_t)(b * 1024 + c)) * 2304 + pos) = o;
  }
}

template <int EPI>
DI float epi8(const Epi& e, int r, int c, f32x4 v0, f32x4 v1, float rinv, float4 s0, float4 s1, float4 t0, float4 t1) {
  if constexpr (EPI == EPI_STORE || EPI == EPI_SQRELU) {
    if (e.stats) {
      v0[0] = v0[0] * rinv + s0.x; v0[1] = v0[1] * rinv + s0.y; v0[2] = v0[2] * rinv + s0.z; v0[3] = v0[3] * rinv + s0.w;
      v1[0] = v1[0] * rinv + s1.x; v1[1] = v1[1] * rinv + s1.y; v1[2] = v1[2] * rinv + s1.z; v1[3] = v1[3] * rinv + s1.w;
    }
  }
  if constexpr (EPI == EPI_F32) {
    if (r < 33) {
      float* d = e.xo + (size_t)r * 4096 + c;
      *(float4*)d = make_float4(v0[0], v0[1], v0[2], v0[3]); *(float4*)(d + 4) = make_float4(v1[0], v1[1], v1[2], v1[3]);
    }
  }
  if constexpr (EPI == EPI_STORE) {
    uint4 o; o.x = pack2(v0[0], v0[1]); o.y = pack2(v0[2], v0[3]); o.z = pack2(v1[0], v1[1]); o.w = pack2(v1[2], v1[3]);
    *(uint4*)(e.o16 + (size_t)r * e.ldo + c) = o;
  } else if constexpr (EPI == EPI_SQRELU) {
    float a0 = fmaxf(v0[0], 0.f), a1 = fmaxf(v0[1], 0.f), a2 = fmaxf(v0[2], 0.f), a3 = fmaxf(v0[3], 0.f);
    float a4 = fmaxf(v1[0], 0.f), a5 = fmaxf(v1[1], 0.f), a6 = fmaxf(v1[2], 0.f), a7 = fmaxf(v1[3], 0.f);
    uint4 o; o.x = pack2(a0 * a0, a1 * a1); o.y = pack2(a2 * a2, a3 * a3); o.z = pack2(a4 * a4, a5 * a5); o.w = pack2(a6 * a6, a7 * a7);
    *(uint4*)(e.o16 + (size_t)r * e.ldo + c) = o;
  } else if constexpr (EPI == EPI_RESID) {
    const float* src; float* dst;
    if (r < NX) { src = e.xi + (size_t)r * 1024 + c; dst = e.xo + (size_t)r * 1024 + c; }
    else { int rc = r - NX; src = e.ci + (size_t)rc * 1024 + c; dst = e.co + (size_t)rc * 1024 + c; }
    float4 x0 = *(const float4*)src, x1 = *(const float4*)(src + 4);
    float4 o0, o1;
    o0.x = x0.x + s0.x * v0[0]; o0.y = x0.y + s0.y * v0[1]; o0.z = x0.z + s0.z * v0[2]; o0.w = x0.w + s0.w * v0[3];
    o1.x = x1.x + s1.x * v1[0]; o1.y = x1.y + s1.y * v1[1]; o1.z = x1.z + s1.z * v1[2]; o1.w = x1.w + s1.w * v1[3];
    *(float4*)dst = o0; *(float4*)(dst + 4) = o1;
    if (e.hout) {
      uint4 h;
      h.x = pack2(o0.x * t0.x, o0.y * t0.y); h.y = pack2(o0.z * t0.z, o0.w * t0.w);
      h.z = pack2(o1.x * t1.x, o1.y * t1.y); h.w = pack2(o1.z * t1.z, o1.w * t1.w);
      *(uint4*)(e.hout + (size_t)r * 1024 + c) = h;
      return (o0.x * o0.x + o0.y * o0.y) + (o0.z * o0.z + o0.w * o0.w) + (o1.x * o1.x + o1.y * o1.y) + (o1.z * o1.z + o1.w * o1.w);
    }
  } else if constexpr (EPI == EPI_GLU) {
    uint4 y = *(const uint4*)(e.a16 + (size_t)r * 512 + c);
    float g0 = 1.f / (1.f + __expf(-(v0[0] + s0.x))), g1 = 1.f / (1.f + __expf(-(v0[1] + s0.y)));
    float g2 = 1.f / (1.f + __expf(-(v0[2] + s0.z))), g3 = 1.f / (1.f + __expf(-(v0[3] + s0.w)));
    float g4 = 1.f / (1.f + __expf(-(v1[0] + s1.x))), g5 = 1.f / (1.f + __expf(-(v1[1] + s1.y)));
    float g6 = 1.f / (1.f + __expf(-(v1[2] + s1.z))), g7 = 1.f / (1.f + __expf(-(v1[3] + s1.w)));
    uint4 o; o.x = pack2(bflo(y.x) * g0, bfhi(y.x) * g1); o.y = pack2(bflo(y.y) * g2, bfhi(y.y) * g3);
    o.z = pack2(bflo(y.z) * g4, bfhi(y.z) * g5); o.w = pack2(bflo(y.w) * g6, bfhi(y.w) * g7);
    *(uint4*)(e.o16 + (size_t)r * 1024 + 512 + c) = o;
  } else if constexpr (EPI == EPI_FT || EPI == EPI_VT) {
    if (e.stats) {
      v0[0] = v0[0] * s0.x + rinv; v0[1] = v0[1] * s0.y + rinv; v0[2] = v0[2] * s0.z + rinv; v0[3] = v0[3] * s0.w + rinv;
      v1[0] = v1[0] * s1.x + rinv; v1[1] = v1[1] * s1.y + rinv; v1[2] = v1[2] * s1.z + rinv; v1[3] = v1[3] * s1.w + rinv;
    }
    int b, pos;
    if (c < NX) { b = c >> 11; pos = c & 2047; } else { const int rc = c - NX; b = rc >> 8; pos = rc & 255; }
    if constexpr (EPI == EPI_FT) {
      const int part = r >> 9, jj = r & 511;
      uint4 o; o.x = pack2(v0[0], v0[1]); o.y = pack2(v0[2], v0[3]); o.z = pack2(v1[0], v1[1]); o.w = pack2(v1[2], v1[3]);
      if (c < NX) *(uint4*)(e.o16 + ((size_t)(b * 512 + jj)) * 4096 + part * 2048 + pos) = o;
      else *(uint4*)(e.o16b + ((size_t)(b * 512 + jj)) * 512 + part * 256 + pos) = o;
    } else {
      if (c >= NX) pos += 2048;
      const int p0 = (pos & ~12) | ((pos & 4) << 1) | ((pos & 8) >> 1);
      const int q1 = pos + 4, p1 = (q1 & ~12) | ((q1 & 4) << 1) | ((q1 & 8) >> 1);
      u16* dst = e.o16 + ((size_t)(b * 1024 + r)) * 2304;
      uint2 oa; oa.x = pack2(v0[0], v0[1]); oa.y = pack2(v0[2], v0[3]);
      uint2 ob; ob.x = pack2(v1[0], v1[1]); ob.y = pack2(v1[2], v1[3]);
      *(uint2*)(dst + p0) = oa; *(uint2*)(dst + p1) = ob;
    }
  } else if constexpr (EPI == EPI_FOUT) {
    int b = c >> 9, cc = c & 511;
    uint4 o; o.x = pack2(v0[0], v0[1]); o.y = pack2(v0[2], v0[3]); o.z = pack2(v1[0], v1[1]); o.w = pack2(v1[2], v1[3]);
    *(uint4*)(e.o16 + ((size_t)e.rowbase + (size_t)b * e.L + r) * 1024 + cc) = o;
  }
  return 0.f;
}

DI int gemm_decode(int T, int nsuper, int nNs, int SWM, int SWN, int nM, int& pm, int& pn) {
  const int sup = T >> 5, within = T & 31;
  if (sup >= nsuper) return -1;
  const int mg = sup / nNs, ng = sup - mg * nNs;
  pm = mg * SWM + within / SWN; pn = ng * SWN + within % SWN;
  return pm < nM ? 1 : 0;
}

template <int EPI>
DI void gemm_phase(const u16* __restrict__ A, int lda, const u16* __restrict__ Bt, int ldb,
                   int M, int N, int K, const Epi& e, unsigned char* shmraw, int wv, int slot) {
  constexpr bool SWAP = (EPI != EPI_TRANS_F && EPI != EPI_TRANS_V);
  u16* shm = (u16*)shmraw;
  const int tidx = ltid(wv);
#define SA(b, h) (shm + ((b) * 2 + (h)) * HT)
#define SB(b, h) (shm + (4 + (b) * 2 + (h)) * HT)
#define STAGEA(P, br, kt) do { const char* _g = uptr(A + (size_t)(br) * lda + (size_t)(kt) * BK); \
    _Pragma("unroll") for (int _i = 0; _i < 2; ++_i) { \
      __builtin_amdgcn_global_load_lds((const unsigned*)(_g + offA[_i]), (unsigned*)((char*)(P) + tidx * 16 + _i * 8192), 16, 0, 0); } } while (0)
#define STAGEB(P, br, kt) do { const char* _g = uptr(Bt + (size_t)(br) * ldb + (size_t)(kt) * BK); \
    _Pragma("unroll") for (int _i = 0; _i < 2; ++_i) { \
      __builtin_amdgcn_global_load_lds((const unsigned*)(_g + offB[_i]), (unsigned*)((char*)(P) + tidx * 16 + _i * 8192), 16, 0, 0); } } while (0)
#define LDA(dst, b, h) _Pragma("unroll") for (int m = 0; m < 4; ++m) _Pragma("unroll") for (int k = 0; k < 2; ++k) \
    dst[m][k] = *reinterpret_cast<const bf16x8*>((char*)SA(b, h) + aoff + m * 2048 + k * 1024)
#define LDB(dst, b, h) _Pragma("unroll") for (int n = 0; n < 2; ++n) _Pragma("unroll") for (int k = 0; k < 2; ++k) \
    dst[n][k] = *reinterpret_cast<const bf16x8*>((char*)SB(b, h) + boff + n * (SWAP ? 256 : 2048) + k * 1024)
#define MMA(ai, bj, AT, BT) do { __builtin_amdgcn_s_setprio(1); \
    _Pragma("unroll") for (int m = 0; m < 4; ++m) _Pragma("unroll") for (int n = 0; n < 2; ++n) _Pragma("unroll") for (int k = 0; k < 2; ++k) { \
      if constexpr (SWAP) acc[ai][bj][m][n] = __builtin_amdgcn_mfma_f32_16x16x32_bf16(BT[n][k], AT[m][k], acc[ai][bj][m][n], 0, 0, 0); \
      else acc[ai][bj][m][n] = __builtin_amdgcn_mfma_f32_16x16x32_bf16(AT[m][k], BT[n][k], acc[ai][bj][m][n], 0, 0, 0); } \
    __builtin_amdgcn_s_setprio(0); } while (0)
#define WAIT_V(n) asm volatile("s_waitcnt vmcnt(" #n ")" ::: "memory")
#define WAIT_L(n) asm volatile("s_waitcnt lgkmcnt(" #n ")" ::: "memory")
#define BAR __builtin_amdgcn_s_barrier()
#define SCHED __builtin_amdgcn_sched_barrier(0)

  const int nM = M / BM, nN = N / BM;
  int SWN = nN < 4 ? nN : 4, SWM = 32 / SWN;
  if (nM < 8) { SWM = 1; SWN = nN < 32 ? nN : 32; }
  if (nM == 4 && (nN & 7) == 0) { SWM = 4; SWN = 8; }
  const int nNs = nN / SWN, nMs = (nM + SWM - 1) / SWM;
  const int nsuper = nNs * nMs;
  const int nb = gridDim.x;
  const int wid = tidx >> 6, lane = tidx & 63, wr = wid >> 2, wc = wid & 3, fr = lane & 15, fq = lane >> 4;
  const int aoff = lds_byte(wr * 64 + fr, fq * 8);
  const int boff = lds_byte(wc * 32 + (SWAP ? ((fr >> 2) * 8 + (fr & 3)) : fr), fq * 8);
  unsigned offA[2], offB[2];
#pragma unroll
  for (int i = 0; i < 2; ++i) { int r_, c_; stage_rc(tidx * 16 + i * 8192, r_, c_); offA[i] = (unsigned)(r_ * lda + c_) * 2u; offB[i] = (unsigned)(r_ * ldb + c_) * 2u; }
  const int nt = K / BK;

  int T = slot, pm = 0, pn = 0, st_;
  while ((st_ = gemm_decode(T, nsuper, nNs, SWM, SWN, nM, pm, pn)) == 0) T += nb;
  if (st_ < 0) return;
#define PROLOGUE_STAGES(br_, bc_) do { \
    STAGEB(SB(0, 0), bc_, 0); STAGEA(SA(0, 0), br_, 0); STAGEB(SB(0, 1), (bc_) + HALF, 0); STAGEA(SA(0, 1), (br_) + HALF, 0); \
    STAGEB(SB(1, 0), bc_, 1); STAGEA(SA(1, 0), br_, 1); STAGEB(SB(1, 1), (bc_) + HALF, 1); } while (0)
  PROLOGUE_STAGES(pm * BM, pn * BM);
  bool first_tile = true;
  for (;;) {
    const int brow = pm * BM, bcol = pn * BM;
    int pm2 = 0, pn2 = 0, st2;
    T += nb;
    while ((st2 = gemm_decode(T, nsuper, nNs, SWM, SWN, nM, pm2, pn2)) == 0) T += nb;
    f32x4 acc[2][2][4][2];
#pragma unroll
    for (int a = 0; a < 2; ++a)
#pragma unroll
      for (int b = 0; b < 2; ++b)
#pragma unroll
        for (int m = 0; m < 4; ++m)
#pragma unroll
          for (int n = 0; n < 2; ++n) acc[a][b][m][n] = f32x4{0.f, 0.f, 0.f, 0.f};
    bf16x8 At[4][2], B0[2][2], B1[2][2];
    if (first_tile) WAIT_V(0);
    else if constexpr (EPI == EPI_STORE || EPI == EPI_SQRELU || EPI == EPI_GLU || EPI == EPI_FOUT || EPI == EPI_FT) WAIT_V(16);
    else if constexpr (EPI == EPI_TRANS_F || EPI == EPI_TRANS_V || EPI == EPI_VT) WAIT_V(32);
    else if constexpr (EPI == EPI_RESID) { if (e.hout) WAIT_V(48); else WAIT_V(32); }
    else WAIT_V(0);
    first_tile = false;
    if (wr == 1) BAR;
    BAR;
    for (int t = 0; t < nt - 2; t += 2) {
      LDB(B0, 0, 0); SCHED; LDA(At, 0, 0); STAGEA(SA(1, 1), brow + HALF, t + 1);
      WAIT_L(8); BAR; WAIT_L(0); MMA(0, 0, At, B0); BAR; SCHED;
      LDB(B1, 0, 1); STAGEB(SB(0, 0), bcol, t + 2);
      BAR; WAIT_L(0); MMA(0, 1, At, B1); BAR;
      LDA(At, 0, 1); STAGEA(SA(0, 0), brow, t + 2);
      BAR; WAIT_L(0); MMA(1, 0, At, B0); BAR; SCHED;
      STAGEB(SB(0, 1), bcol + HALF, t + 2);
      WAIT_V(6); BAR; MMA(1, 1, At, B1); BAR;
      LDB(B0, 1, 0); SCHED; LDA(At, 1, 0); STAGEA(SA(0, 1), brow + HALF, t + 2);
      WAIT_L(8); BAR; WAIT_L(0); MMA(0, 0, At, B0); BAR; SCHED;
      LDB(B1, 1, 1); STAGEB(SB(1, 0), bcol, t + 3);
      BAR; WAIT_L(0); MMA(0, 1, At, B1); BAR;
      LDA(At, 1, 1); STAGEA(SA(1, 0), brow, t + 3);
      BAR; WAIT_L(0); MMA(1, 0, At, B0); BAR; SCHED;
      STAGEB(SB(1, 1), bcol + HALF, t + 3);
      WAIT_V(6); BAR; MMA(1, 1, At, B1); BAR;
    }
    { LDB(B0, 0, 0); LDA(At, 0, 0); STAGEA(SA(1, 1), brow + HALF, nt - 1);
      BAR; WAIT_L(0); MMA(0, 0, At, B0); BAR;
      LDB(B1, 0, 1); BAR; WAIT_L(0); MMA(0, 1, At, B1); BAR;
      LDA(At, 0, 1); WAIT_V(4); BAR; WAIT_L(0); MMA(1, 0, At, B0); MMA(1, 1, At, B1); BAR; }
    { LDB(B0, 1, 0); LDA(At, 1, 0); WAIT_V(2); BAR; WAIT_L(0); MMA(0, 0, At, B0); BAR;
      LDB(B1, 1, 1); WAIT_V(0); BAR; WAIT_L(0); MMA(0, 1, At, B1); BAR;
      LDA(At, 1, 1); BAR; WAIT_L(0); MMA(1, 0, At, B0); MMA(1, 1, At, B1); BAR; }
    if (wr == 0) BAR;
    if (st2 > 0) PROLOGUE_STAGES(pm2 * BM, pn2 * BM);
    asm volatile("" ::: "memory");
    const int t2_ = ltid(wv); const int wid2 = t2_ >> 6, lane2 = t2_ & 63, wr2 = wid2 >> 2, wc2 = wid2 & 3, fr2 = lane2 & 15, fq2 = lane2 >> 4;
    const int tokbase_t = (EPI == EPI_FT || EPI == EPI_VT) ? bcol : brow;
    const int mrow_t = (tokbase_t < NX) ? (tokbase_t >> 11) : 32;
    if constexpr (SWAP) {
      float4 cs[2][2], ct[2][2];
#pragma unroll
      for (int bj = 0; bj < 2; ++bj) {
        const int c = bcol + bj * HALF + wc2 * 32 + fq2 * 8;
        cs[bj][0] = cs[bj][1] = ct[bj][0] = ct[bj][1] = make_float4(0.f, 0.f, 0.f, 0.f);
        if constexpr (EPI == EPI_FT || EPI == EPI_VT) {
          if (e.stats) { f32x4 ra = row_rinv4(e.stats, c), rb = row_rinv4(e.stats, c + 4); cs[bj][0] = make_float4(ra[0], ra[1], ra[2], ra[3]); cs[bj][1] = make_float4(rb[0], rb[1], rb[2], rb[3]); }
        } else if constexpr (EPI == EPI_STORE || EPI == EPI_SQRELU) {
          if (e.stats) { const float* sp = e.shw + (size_t)mrow_t * 4096 + c; cs[bj][0] = *(const float4*)sp; cs[bj][1] = *(const float4*)(sp + 4); }
        } else if constexpr (EPI == EPI_RESID) {
          const float* gp = e.gate + (size_t)mrow_t * 6144 + c; cs[bj][0] = *(const float4*)gp; cs[bj][1] = *(const float4*)(gp + 4);
          if (e.hout) {
            const float* np = e.ngain + c; const float* scp = e.nscale + (size_t)mrow_t * 6144 + c;
            float4 n0 = *(const float4*)np, n1 = *(const float4*)(np + 4), c0 = *(const float4*)scp, c1 = *(const float4*)(scp + 4);
            ct[bj][0] = make_float4(n0.x * (1.f + c0.x), n0.y * (1.f + c0.y), n0.z * (1.f + c0.z), n0.w * (1.f + c0.w));
            ct[bj][1] = make_float4(n1.x * (1.f + c1.x), n1.y * (1.f + c1.y), n1.z * (1.f + c1.z), n1.w * (1.f + c1.w));
          }
        } else if constexpr (EPI == EPI_GLU) {
          cs[bj][0] = *(const float4*)(e.bias + c); cs[bj][1] = *(const float4*)(e.bias + c + 4);
        }
      }
      float rowss[2][4];
#pragma unroll
      for (int ai = 0; ai < 2; ++ai)
#pragma unroll
        for (int m = 0; m < 4; ++m) {
          const int row = brow + ai * HALF + wr2 * 64 + m * 16 + fr2;
          float rinv = 1.f;
          if constexpr (EPI == EPI_STORE || EPI == EPI_SQRELU) { if (e.stats) rinv = row_rinv(e.stats, row); }
          if constexpr (EPI == EPI_FT || EPI == EPI_VT) { rinv = e.stats ? e.shw[(size_t)mrow_t * 4096 + row] : 0.f; }
          float ss = 0.f;
#pragma unroll
          for (int bj = 0; bj < 2; ++bj)
            ss += epi8<EPI>(e, row, bcol + bj * HALF + wc2 * 32 + fq2 * 8, acc[ai][bj][m][0], acc[ai][bj][m][1], rinv, cs[bj][0], cs[bj][1], ct[bj][0], ct[bj][1]);
          rowss[ai][m] = ss;
        }
      if constexpr (EPI == EPI_RESID) {
        if (e.hout) {
          float* red = (float*)SA(1, 1);
#pragma unroll
          for (int ai = 0; ai < 2; ++ai)
#pragma unroll
            for (int m = 0; m < 4; ++m) {
              float v = rowss[ai][m];
              v += shx(v, 16, lane2); v += shx(v, 32, lane2);
              if (fq2 == 0) red[(ai * HALF + wr2 * 64 + m * 16 + fr2) * 4 + wc2] = v;
            }
          WAIT_L(0); BAR;
          if (t2_ < 256) {
            float4 q = *(const float4*)(red + t2_ * 4);
            e.stats_out[(size_t)pn * NT + brow + t2_] = (q.x + q.y) + (q.z + q.w);
          }
        }
      }
    } else {
      float shv[2][2];
#pragma unroll
      for (int bj = 0; bj < 2; ++bj)
#pragma unroll
        for (int n = 0; n < 2; ++n) shv[bj][n] = e.stats ? e.shw[(size_t)mrow_t * 4096 + bcol + bj * HALF + wc2 * 32 + n * 16 + fr2] : 0.f;
#pragma unroll
      for (int ai = 0; ai < 2; ++ai)
#pragma unroll
        for (int m = 0; m < 4; ++m) {
          const int row4 = brow + ai * HALF + wr2 * 64 + m * 16 + fq2 * 4;
          f32x4 rinv4 = {1.f, 1.f, 1.f, 1.f};
          if (e.stats) rinv4 = row_rinv4(e.stats, row4);
#pragma unroll
          for (int bj = 0; bj < 2; ++bj)
#pragma unroll
            for (int n = 0; n < 2; ++n) epi4<EPI>(e, row4, bcol + bj * HALF + wc2 * 32 + n * 16 + fr2, acc[ai][bj][m][n], rinv4, shv[bj][n]);
        }
    }
    if (st2 < 0) break;
    pm = pm2; pn = pn2;
  }
  WAIT_V(0);
#undef PROLOGUE_STAGES
#undef SA
#undef SB
#undef STAGEA
#undef STAGEB
#undef LDA
#undef LDB
#undef MMA
}

DI void transpose_mat(const float* __restrict__ src, int ldn, int n0, int K, int N, u16* __restrict__ dst, float* lds, int wv) {
  const int tilesN = N / 64, ntile = (K / 64) * tilesN, tid = ltid(wv);
  for (int t = blockIdx.x; t < ntile; t += gridDim.x) {
    const int tk = t / tilesN, tn = t - tk * tilesN, k0 = tk * 64, nn0 = tn * 64;
    const int r = tid >> 4, c4 = (tid & 15) * 4;
#pragma unroll
    for (int i = 0; i < 2; ++i) {
      int rr = r + 32 * i;
      float4 v = *(const float4*)(src + (size_t)(k0 + rr) * ldn + n0 + nn0 + c4);
      lds[rr * 65 + c4 + 0] = v.x; lds[rr * 65 + c4 + 1] = v.y; lds[rr * 65 + c4 + 2] = v.z; lds[rr * 65 + c4 + 3] = v.w;
    }
    __syncthreads();
    const int n = tid >> 3, kc = (tid & 7) * 8;
    uint4 o;
    o.x = pack2(lds[(kc + 0) * 65 + n], lds[(kc + 1) * 65 + n]);
    o.y = pack2(lds[(kc + 2) * 65 + n], lds[(kc + 3) * 65 + n]);
    o.z = pack2(lds[(kc + 4) * 65 + n], lds[(kc + 5) * 65 + n]);
    o.w = pack2(lds[(kc + 6) * 65 + n], lds[(kc + 7) * 65 + n]);
    *(uint4*)(dst + (size_t)(nn0 + n) * K + k0 + kc) = o;
    __syncthreads();
  }
}

DI void phase_prep(const Params& p, unsigned char* shm, int wv) {
  float* lds = (float*)shm;
  unsigned char* ws = p.ws;
  const int tid = ltid(wv), lane = tid & 63, w = tid >> 6;
  for (int i = 0; i < 4; ++i) {
    transpose_mat(p.in[8] + (size_t)i * 1024 * 4096, 4096, 0, 1024, 4096, (u16*)(ws + OFF_W1T) + (size_t)i * 4096 * 1024, lds, wv);
    transpose_mat(p.in[9] + (size_t)i * 4096 * 1024, 1024, 0, 4096, 1024, (u16*)(ws + OFF_W2T) + (size_t)i * 4096 * 1024, lds, wv);
  }
  for (int j = 0; j < 2; ++j) {
    transpose_mat(p.in[10] + (size_t)j * 1024 * 1024, 1024, 512, 1024, 512, (u16*)(ws + OFF_EVIN) + (size_t)j * 1536 * 1024 + 1024 * 1024, lds, wv);
    transpose_mat(p.in[11] + (size_t)j * 1024 * 1024, 1024, 0, 1024, 1024, (u16*)(ws + OFF_EVOUT) + (size_t)j * 1024 * 1024, lds, wv);
    transpose_mat(p.in[20] + (size_t)j * 512 * 512, 512, 0, 512, 512, (u16*)(ws + OFF_GLU) + (size_t)j * 512 * 512, lds, wv);
    transpose_mat(p.in[22] + (size_t)j * 1024 * 3072, 3072, 0, 1024, 3072, (u16*)(ws + OFF_ODIN) + (size_t)j * 3072 * 1024, lds, wv);
    transpose_mat(p.in[23] + (size_t)j * 1024 * 1024, 1024, 0, 1024, 1024, (u16*)(ws + OFF_ODOUT) + (size_t)j * 1024 * 1024, lds, wv);
  }
  for (int t = blockIdx.x; t < 128; t += gridDim.x) {
    const int j = t >> 6, g = (t >> 4) & 3, k0 = (t & 15) * 64;
    float* wl = lds; float* tab = lds + 8192;
    __syncthreads();
#pragma unroll
    for (int i = 0; i < 16; ++i) {
      int idx = tid + 512 * i, kk = idx >> 7, c = idx & 127;
      wl[idx] = p.in[10][((size_t)j * 1024 + k0 + kk) * 1024 + g * 128 + c];
    }
    if (tid < 128) { tab[tid] = cospif(tid * (1.f / 64.f)); tab[128 + tid] = sinpif(tid * (1.f / 64.f)); }
    __syncthreads();
    const int pc = tid & 255, part = pc >> 7, cp = pc & 127, kh = tid >> 8;
    float acc[32];
#pragma unroll
    for (int kk = 0; kk < 32; ++kk) acc[kk] = 0.f;
    for (int c = 0; c < 128; ++c) {
      const float tv = tab[part * 128 + ((c * cp) & 127)];
#pragma unroll
      for (int kk = 0; kk < 32; ++kk) acc[kk] += wl[(kh * 32 + kk) * 128 + c] * tv;
    }
    const float sc = 0.08838834764831845f;
    u16* dst = (u16*)(ws + OFF_EVIN) + (size_t)j * 1536 * 1024 + (size_t)(part * 512 + g * 128 + cp) * 1024 + k0 + kh * 32;
#pragma unroll
    for (int q = 0; q < 4; ++q) {
      uint4 o;
      o.x = pack2(acc[q * 8 + 0] * sc, acc[q * 8 + 1] * sc); o.y = pack2(acc[q * 8 + 2] * sc, acc[q * 8 + 3] * sc);
      o.z = pack2(acc[q * 8 + 4] * sc, acc[q * 8 + 5] * sc); o.w = pack2(acc[q * 8 + 6] * sc, acc[q * 8 + 7] * sc);
      *(uint4*)(dst + q * 8) = o;
    }
  }
  {
    const int gt = blockIdx.x * 512 + tid, nth = gridDim.x * 512;
    u16* F = (u16*)(ws + OFF_F2048);
    const float s = 0.022097086912079608f;
    for (int idx = gt; idx < 2048 * 512; idx += nth) {
      const int lp = idx >> 9, k8 = (idx & 511) * 8;
      float v[8];
#pragma unroll
      for (int jj = 0; jj < 8; ++jj) {
        int k = k8 + jj;
        if (k < 2048) { int m = (k * lp) & 2047; v[jj] = cospif(m * (1.f / 1024.f)) * s; }
        else { int m = ((k - 2048) * lp) & 2047; v[jj] = -sinpif(m * (1.f / 1024.f)) * s; }
      }
      uint4 o; o.x = pack2(v[0], v[1]); o.y = pack2(v[2], v[3]); o.z = pack2(v[4], v[5]); o.w = pack2(v[6], v[7]);
      *(uint4*)(F + (size_t)lp * 4096 + k8) = o;
    }
    u16* F2 = (u16*)(ws + OFF_F256);
    for (int idx = gt; idx < 256 * 64; idx += nth) {
      const int lp = idx >> 6, k8 = (idx & 63) * 8;
      float v[8];
#pragma unroll
      for (int jj = 0; jj < 8; ++jj) {
        int k = k8 + jj;
        if (k < 256) { int m = (k * lp) & 255; v[jj] = cospif(m * (1.f / 128.f)) * 0.0625f; }
        else { int m = ((k - 256) * lp) & 255; v[jj] = -sinpif(m * (1.f / 128.f)) * 0.0625f; }
      }
      uint4 o; o.x = pack2(v[0], v[1]); o.y = pack2(v[2], v[3]); o.z = pack2(v[4], v[5]); o.w = pack2(v[6], v[7]);
      *(uint4*)(F2 + (size_t)lp * 512 + k8) = o;
    }
  }
  {
    float* modv = (float*)(ws + OFF_MODV);
    float* sl = lds + w * (33 * 64);
    float* red = lds;
    for (int t = blockIdx.x; t < 384; t += gridDim.x) {
      const int i = t / 96, n0 = (t % 96) * 64, n = n0 + lane;
      float acc[33];
#pragma unroll
      for (int r = 0; r < 33; ++r) acc[r] = 0.f;
      const float* wbase = p.in[6] + (size_t)i * 1024 * 6144 + n;
      __syncthreads();
      for (int half = 0; half < 2; ++half) {
        const int kbase = w * 128 + half * 64;
        __builtin_amdgcn_wave_barrier();
#pragma unroll
        for (int r = 0; r < 33; ++r) {
          const float cv = (r < 32) ? p.in[1][r * 1024 + kbase + lane] : p.in[3][kbase + lane];
          sl[r * 64 + lane] = cv / (1.f + __expf(-cv));
        }
        __builtin_amdgcn_wave_barrier();
        for (int k = 0; k < 64; k += 16) {
          float wv16[16];
#pragma unroll
          for (int u = 0; u < 16; ++u) wv16[u] = wbase[(size_t)(kbase + k + u) * 6144];
#pragma unroll
          for (int r = 0; r < 33; ++r) {
            const float* sp = sl + r * 64 + k;
            float4 s0 = *(const float4*)sp, s1 = *(const float4*)(sp + 4), s2 = *(const float4*)(sp + 8), s3 = *(const float4*)(sp + 12);
            acc[r] += s0.x * wv16[0] + s0.y * wv16[1] + s0.z * wv16[2] + s0.w * wv16[3] + s1.x * wv16[4] + s1.y * wv16[5] + s1.z * wv16[6] + s1.w * wv16[7]
                    + s2.x * wv16[8] + s2.y * wv16[9] + s2.z * wv16[10] + s2.w * wv16[11] + s3.x * wv16[12] + s3.y * wv16[13] + s3.z * wv16[14] + s3.w * wv16[15];
          }
        }
      }
      __syncthreads();
#pragma unroll
      for (int r = 0; r < 33; ++r) red[(w * 33 + r) * 64 + lane] = acc[r];
      __syncthreads();
      for (int o = tid; o < 33 * 64; o += 512) {
        const int r = o >> 6, c = o & 63;
        float sum = 0.f;
#pragma unroll
        for (int ww = 0; ww < 8; ++ww) sum += red[(ww * 33 + r) * 64 + c];
        modv[((size_t)i * 33 + r) * 6144 + n0 + c] = sum + p.in[7][i * 6144 + n0 + c];
      }
    }
  }
}

DI void phase_sh(const Params& p, int wv) {
  const float* modv = (const float*)(p.ws + OFF_MODV);
  u16* SH = (u16*)(p.ws + OFF_SH);
  const int gt = blockIdx.x * 512 + ltid(wv), nth = gridDim.x * 512;
  for (int idx = gt; idx < 8 * 33 * 128; idx += nth) {
    const int q = idx / (33 * 128), rem = idx - q * (33 * 128), r = rem >> 7, k8 = (rem & 127) * 8;
    const int i = q >> 1, chunk = (q & 1) ? 3 : 0;
    const float* src = modv + ((size_t)i * 33 + r) * 6144 + chunk * 1024 + k8;
    float4 a = *(const float4*)src, b = *(const float4*)(src + 4);
    uint4 o; o.x = pack2(a.x, a.y); o.y = pack2(a.z, a.w); o.z = pack2(b.x, b.y); o.w = pack2(b.z, b.w);
    *(uint4*)(SH + ((size_t)q * 256 + r) * 1024 + k8) = o;
  }
}

DI void phase_norm(const Params& p, int layer, int which, const float* xsrc, const float* csrc, int nrows, int wv) {
  const int tid = ltid(wv); const int lane = tid & 63, w = tid >> 6;
  const float* g = p.in[which == 1 ? 4 : 5] + layer * 1024;
  const float* modv = (const float*)(p.ws + OFF_MODV) + (size_t)layer * 33 * 6144;
  u16* H = (u16*)(p.ws + OFF_H);
  const int shc = (which == 1 ? 0 : 3) * 1024, scc = (which == 1 ? 1 : 4) * 1024;
  const int rstride = gridDim.x * 8;
  int row = blockIdx.x * 8 + w;
  float4 nv[4];
  if (row < nrows) {
    const float* src = (row < NX) ? xsrc + (size_t)row * 1024 : csrc + (size_t)(row - NX) * 1024;
#pragma unroll
    for (int i = 0; i < 4; ++i) nv[i] = *(const float4*)(src + (lane + 64 * i) * 4);
  }
  for (; row < nrows; row += rstride) {
    const int mrow = (row < NX) ? (row >> 11) : 32;
    const float* mv = modv + (size_t)mrow * 6144;
    float4 v[4]; float ss = 0.f;
#pragma unroll
    for (int i = 0; i < 4; ++i) { v[i] = nv[i]; ss += v[i].x * v[i].x + v[i].y * v[i].y + v[i].z * v[i].z + v[i].w * v[i].w; }
    const int nrow = row + rstride;
    if (nrow < nrows) {
      const float* src = (nrow < NX) ? xsrc + (size_t)nrow * 1024 : csrc + (size_t)(nrow - NX) * 1024;
#pragma unroll
      for (int i = 0; i < 4; ++i) nv[i] = *(const float4*)(src + (lane + 64 * i) * 4);
    }
    ss = wave_sum(ss, lane);
    const float rinv = rsqrtf(ss * (1.f / 1024.f) + 1e-6f);
#pragma unroll
    for (int i = 0; i < 4; ++i) {
      const int col = (lane + 64 * i) * 4;
      float4 gg = *(const float4*)(g + col), sc = *(const float4*)(mv + scc + col), sh = *(const float4*)(mv + shc + col);
      float y0 = v[i].x * rinv * gg.x * (1.f + sc.x) + sh.x, y1 = v[i].y * rinv * gg.y * (1.f + sc.y) + sh.y;
      float y2 = v[i].z * rinv * gg.z * (1.f + sc.z) + sh.z, y3 = v[i].w * rinv * gg.w * (1.f + sc.w) + sh.w;
      uint2 o; o.x = pack2(y0, y1); o.y = pack2(y2, y3);
      *(uint2*)(H + (size_t)row * 1024 + col) = o;
    }
  }
}

DI void phase_qknorm(const Params& p, int j, int wv) {
  const int tid = ltid(wv); const int lane = tid & 63, w = tid >> 6;
  const int tsel = lane >> 5, hh = (lane >> 1) & 15, axis = lane & 1;
  const int qk = 1;
  u16* QKB = (u16*)(p.ws + R_QKB);
  const float* gam = p.in[qk ? 25 : 24] + j * 64 + axis * 32;
  float gm[32];
#pragma unroll
  for (int d = 0; d < 32; ++d) gm[d] = gam[d];
  const float qscale = qk ? 1.f : 0.125f * 1.4426950408889634f;
  const int rstride = gridDim.x * 16;
  const int lcol = qk * 1024 + hh * 64 + axis * 32;
  uint4 nu[4];
  {
    const int row0 = (blockIdx.x * 8 + w) * 2 + tsel;
    if (row0 < NT) {
#pragma unroll
      for (int q = 0; q < 4; ++q) nu[q] = *(const uint4*)(QKB + (size_t)row0 * 2048 + lcol + q * 8);
    }
  }
  for (int row = (blockIdx.x * 8 + w) * 2 + tsel; row < NT; row += rstride) {
    u16* ptr = QKB + (size_t)row * 2048 + lcol;
    float v[32]; float ss = 0.f;
    uint4 cu[4];
#pragma unroll
    for (int q = 0; q < 4; ++q) cu[q] = nu[q];
    if (row + rstride < NT) {
#pragma unroll
      for (int q = 0; q < 4; ++q) nu[q] = *(const uint4*)(QKB + (size_t)(row + rstride) * 2048 + lcol + q * 8);
    }
#pragma unroll
    for (int q = 0; q < 4; ++q) {
      uint4 u = cu[q];
      v[q * 8 + 0] = bflo(u.x); v[q * 8 + 1] = bfhi(u.x); v[q * 8 + 2] = bflo(u.y); v[q * 8 + 3] = bfhi(u.y);
      v[q * 8 + 4] = bflo(u.z); v[q * 8 + 5] = bfhi(u.z); v[q * 8 + 6] = bflo(u.w); v[q * 8 + 7] = bfhi(u.w);
    }
#pragma unroll
    for (int d = 0; d < 32; ++d) ss += v[d] * v[d];
    ss += shx(ss, 1, lane);
    const float rinv = rsqrtf(ss * (1.f / 64.f) + 1e-6f);
#pragma unroll
    for (int d = 0; d < 32; ++d) v[d] = v[d] * rinv * gm[d];
    if (row < NX) {
      const int l = row & 2047;
      const float pos = (float)(axis ? (l & 63) : (l >> 6));
#pragma unroll
      for (int i2 = 0; i2 < 16; ++i2) {
        const float invf = exp2f(-(float)i2 * 0.8304820237218406f);
        const float ang = pos * invf;
        float sn, cs; __sincosf(ang, &sn, &cs);
        const float x1 = v[i2], x2 = v[16 + i2];
        v[i2] = x1 * cs - x2 * sn; v[16 + i2] = x1 * sn + x2 * cs;
      }
    }
#pragma unroll
    for (int q = 0; q < 4; ++q) {
      uint4 o;
      o.x = pack2(v[q * 8 + 0] * qscale, v[q * 8 + 1] * qscale); o.y = pack2(v[q * 8 + 2] * qscale, v[q * 8 + 3] * qscale);
      o.z = pack2(v[q * 8 + 4] * qscale, v[q * 8 + 5] * qscale); o.w = pack2(v[q * 8 + 6] * qscale, v[q * 8 + 7] * qscale);
      *(uint4*)(ptr + q * 8) = o;
    }
  }
}

#define MFMA32(a, b, c) __builtin_amdgcn_mfma_f32_32x32x16_bf16((a), (b), (c), 0, 0, 0)
DI void phase_attn(const Params& p, int j, float lam_init, bool last, unsigned char* shm, int wv, int slot) {
  const u16* QKB = (const u16*)(p.ws + R_QKB);
  const u16* VT = (const u16*)(p.ws + R_VT);
  u16* OB = (u16*)(p.ws + R_MIX);
  const int tid = ltid(wv), lane = tid & 63, w = tid >> 6;
  const int r = lane & 31, hh = lane >> 5, qsub = w >> 1, map = w & 1;
  float lam;
  {
    const float* lp = p.in[26] + j * 256;
    float a = lp[lane] * lp[64 + lane], b = lp[128 + lane] * lp[192 + lane];
    a = wave_sum(a, lane); b = wave_sum(b, lane);
    lam = __expf(a) - __expf(b) + lam_init;
  }
  bool fastsm;
  {
    float gq = fabsf(p.in[24][j * 64 + lane]), gk = fabsf(p.in[25][j * 64 + lane]);
#pragma unroll
    for (int o = 32; o >= 1; o >>= 1) { gq = fmaxf(gq, shx(gq, o, lane)); gk = fmaxf(gk, shx(gk, o, lane)); }
    const float bound = 11.6f * gq * gk;
    fastsm = __builtin_amdgcn_readfirstlane((int)(bound <= 100.f)) != 0;
  }
  const float* ghead = p.in[27] + j * 128;
  const int ntask = 4096 + (last ? 0 : 512);
  const int nb = gridDim.x;
  const int krow = tid >> 3, kch = tid & 7;
  if (wv >= 4) __builtin_amdgcn_s_setprio(1);
  for (int task = slot; task < ntask; task += nb) {
    int b, head, qrow0, kt0, nkt;
    if (task < 4096) { b = task >> 7; head = (task >> 4) & 7; qrow0 = b * 2048 + (task & 15) * 128; kt0 = 0; nkt = 36; }
    else { int t2 = task - 4096; b = t2 >> 4; head = (t2 >> 1) & 7; qrow0 = NX + b * 256 + (t2 & 1) * 128; kt0 = 32; nkt = 4; }
    const u16* vbase = VT + ((size_t)(b * 8 + head) * 128) * 2304;
    f32x16 O[4];
#pragma unroll
    for (int d = 0; d < 4; ++d)
#pragma unroll
      for (int i = 0; i < 16; ++i) O[d][i] = 0.f;
    float m_run = 0.f, l_run = 0.f;
    const int drow = w * 8 + (lane >> 3); const int dcg = (lane & 7) ^ ((drow >> 1) & 7);
    const u16* kptr = QKB + (size_t)((kt0 < 32) ? (b * 2048 + kt0 * 64 + drow) : (NX + b * 256 + (kt0 - 32) * 64 + drow)) * 2048 + 1024 + head * 128 + dcg * 8;
    const u16* vptr = vbase + (size_t)drow * 2304 + kt0 * 64 + dcg * 8;
    const u16* vptr2 = vptr + (size_t)64 * 2304;
    const unsigned ldsoff = w * 1024 + lane * 16;
    int dma_kt = kt0;
#define DMA_TILE(kt_, ks_, vs_) do { \
      unsigned char* kdst = shm + (ks_) * 16384 + ldsoff; \
      unsigned char* vdst = shm + 49152 + (vs_) * 16384 + ldsoff; \
      __builtin_amdgcn_global_load_lds((const unsigned*)kptr, (unsigned*)kdst, 16, 0, 0); \
      __builtin_amdgcn_global_load_lds((const unsigned*)(kptr + 64), (unsigned*)(kdst + 8192), 16, 0, 0); \
      __builtin_amdgcn_global_load_lds((const unsigned*)vptr, (unsigned*)vdst, 16, 0, 0); \
      __builtin_amdgcn_global_load_lds((const unsigned*)vptr2, (unsigned*)(vdst + 8192), 16, 0, 0); \
      ++dma_kt; vptr += 64; vptr2 += 64; \
      if (dma_kt == 32) kptr = QKB + (size_t)(NX + b * 256 + drow) * 2048 + 1024 + head * 128 + dcg * 8;     \
      else kptr += (size_t)64 * 2048; } while (0)
    const int swz = ((r >> 1) & 7);
#define QK_SOFTMAX(ks_, FAST_) do { \
      const unsigned char* kb_ = shm + (ks_) * 16384 + map * 8192; \
      f32x16 S[2]; \
      bf16x8 kf[2][4]; \
      _Pragma("unroll") for (int kb = 0; kb < 2; ++kb) _Pragma("unroll") for (int kk = 0; kk < 4; ++kk) \
        kf[kb][kk] = *(const bf16x8*)(kb_ + (kb * 32 + r) * 128 + (((kk * 2 + hh) ^ swz) << 4)); \
      _Pragma("unroll") for (int kb = 0; kb < 2; ++kb) _Pragma("unroll") for (int i = 0; i < 16; ++i) S[kb][i] = (FAST_) ? 0.f : -m_run; \
      __builtin_amdgcn_sched_barrier(0); \
      _Pragma("unroll") for (int kk = 0; kk < 4; ++kk) _Pragma("unroll") for (int kb = 0; kb < 2; ++kb) \
        S[kb] = MFMA32(kf[kb][kk], qf[kk], S[kb]); \
      __builtin_amdgcn_sched_barrier(0); \
      if (!(FAST_)) {   \
      float mx = S[0][0]; \
      _Pragma("unroll") for (int i = 1; i < 16; ++i) mx = fmaxf(mx, S[0][i]); \
      _Pragma("unroll") for (int i = 0; i < 16; ++i) mx = fmaxf(mx, S[1][i]); \
      mx = fmaxf(mx, shx(mx, 32, lane)); \
      const bool need = (it == 0) || (mx > 8.f); \
      if (__builtin_amdgcn_ballot_w64(need) != 0ull) { \
        const float delta = need ? mx : 0.f; \
        const float alpha = __builtin_amdgcn_exp2f(-delta); \
        m_run += delta; l_run *= alpha; \
        _Pragma("unroll") for (int d = 0; d < 4; ++d) _Pragma("unroll") for (int i = 0; i < 16; ++i) O[d][i] *= alpha; \
        _Pragma("unroll") for (int kb = 0; kb < 2; ++kb) _Pragma("unroll") for (int i = 0; i < 16; ++i) S[kb][i] -= delta; } } \
      float ps = 0.f; \
      _Pragma("unroll") for (int kb = 0; kb < 2; ++kb) _Pragma("unroll") for (int i = 0; i < 16; ++i) { float e_ = __builtin_amdgcn_exp2f(S[kb][i]); S[kb][i] = e_; ps += e_; } \
      l_run += ps; \
      _Pragma("unroll") for (int kb = 0; kb < 2; ++kb) _Pragma("unroll") for (int s2 = 0; s2 < 2; ++s2) _Pragma("unroll") for (int q4 = 0; q4 < 4; ++q4) \
        Pk[(kb * 2 + s2) * 4 + q4] = pack2(S[kb][8 * s2 + 2 * q4], S[kb][8 * s2 + 2 * q4 + 1]); } while (0)
#define PV(vs_) do { \
      const unsigned char* vb_ = shm + 49152 + (vs_) * 16384; \
      bf16x8 vf[4][4]; \
      _Pragma("unroll") for (int ks4 = 0; ks4 < 4; ++ks4) _Pragma("unroll") for (int d = 0; d < 4; ++d) \
        vf[ks4][d] = *(const bf16x8*)(vb_ + (d * 32 + r) * 128 + (((ks4 * 2 + hh) ^ swz) << 4)); \
      __builtin_amdgcn_sched_barrier(0); \
      _Pragma("unroll") for (int ks4 = 0; ks4 < 4; ++ks4) { \
        uint4 pu = make_uint4(Pk[ks4 * 4 + 0], Pk[ks4 * 4 + 1], Pk[ks4 * 4 + 2], Pk[ks4 * 4 + 3]); \
        bf16x8 pf = __builtin_bit_cast(bf16x8, pu); \
        _Pragma("unroll") for (int d = 0; d < 4; ++d) O[d] = MFMA32(vf[ks4][d], pf, O[d]); } \
      __builtin_amdgcn_sched_barrier(0); } while (0)
    unsigned Pk[16];
#pragma unroll
    for (int i = 0; i < 16; ++i) Pk[i] = 0u;
    DMA_TILE(kt0, 0, 0);
    if (1 < nkt) DMA_TILE(kt0 + 1, 1, 1);
    bf16x8 qf[4];
    {
      const int qtok = qrow0 + qsub * 32 + r;
      const u16* qp = QKB + (size_t)qtok * 2048 + head * 128 + map * 64 + hh * 8;
      float v[4][8]; float ss = 0.f;
#pragma unroll
      for (int kk = 0; kk < 4; ++kk) {
        uint4 u = *(const uint4*)(qp + kk * 16);
        v[kk][0] = bflo(u.x); v[kk][1] = bfhi(u.x); v[kk][2] = bflo(u.y); v[kk][3] = bfhi(u.y);
        v[kk][4] = bflo(u.z); v[kk][5] = bfhi(u.z); v[kk][6] = bflo(u.w); v[kk][7] = bfhi(u.w);
      }
#pragma unroll
      for (int kk = 0; kk < 4; ++kk)
#pragma unroll
        for (int jq = 0; jq < 8; ++jq) ss += v[kk][jq] * v[kk][jq];
      ss += shx(ss, 32, lane);
      const float rinv = rsqrtf(ss * (1.f / 64.f) + 1e-6f);
      const float* gq = p.in[24] + j * 64 + hh * 8;
#pragma unroll
      for (int kk = 0; kk < 4; ++kk) {
        float4 g0 = *(const float4*)(gq + kk * 16), g1 = *(const float4*)(gq + kk * 16 + 4);
        v[kk][0] *= rinv * g0.x; v[kk][1] *= rinv * g0.y; v[kk][2] *= rinv * g0.z; v[kk][3] *= rinv * g0.w;
        v[kk][4] *= rinv * g1.x; v[kk][5] *= rinv * g1.y; v[kk][6] *= rinv * g1.z; v[kk][7] *= rinv * g1.w;
      }
      if (task < 4096) {
        const int l = qtok & 2047;
        const float prow = (float)(l >> 6), pcol = (float)(l & 63);
#pragma unroll
        for (int jq = 0; jq < 8; ++jq) {
          const float invf = exp2f(-(float)(hh * 8 + jq) * 0.8304820237218406f);
          float sn, cs;
          __sincosf(prow * invf, &sn, &cs);
          { const float x1 = v[0][jq], x2 = v[1][jq]; v[0][jq] = x1 * cs - x2 * sn; v[1][jq] = x1 * sn + x2 * cs; }
          __sincosf(pcol * invf, &sn, &cs);
          { const float x1 = v[2][jq], x2 = v[3][jq]; v[2][jq] = x1 * cs - x2 * sn; v[3][jq] = x1 * sn + x2 * cs; }
        }
      }
      const float qs = 0.125f * 1.4426950408889634f;
#pragma unroll
      for (int kk = 0; kk < 4; ++kk) {
        uint4 o = make_uint4(pack2(v[kk][0] * qs, v[kk][1] * qs), pack2(v[kk][2] * qs, v[kk][3] * qs), pack2(v[kk][4] * qs, v[kk][5] * qs), pack2(v[kk][6] * qs, v[kk][7] * qs));
        qf[kk] = __builtin_bit_cast(bf16x8, o);
      }
    }
    if (1 < nkt) asm volatile("s_waitcnt vmcnt(4)" ::: "memory");
    else asm volatile("s_waitcnt vmcnt(0)" ::: "memory");
    __builtin_amdgcn_s_barrier();
    int ks = 0, vs = 0;
#define ATT_COMPUTE(FAST_) do { \
      if (map == 0) { QK_SOFTMAX(ks, FAST_); PV(vs); } \
      else { const int vsp = (vs + 3) & 3; if (it > 0) PV(vsp); QK_SOFTMAX(ks, FAST_); } } while (0)
#define ATT_LOOP(FAST_) \
    for (int it = 0; it < nkt; ++it) { \
      const int ks2 = (ks == 0) ? 2 : ks - 1; \
      if (it + 2 < nkt) DMA_TILE(kt0 + it + 2, ks2, (vs + 2) & 3); \
      ATT_COMPUTE(FAST_); \
      if (it + 2 < nkt) asm volatile("s_waitcnt vmcnt(4)" ::: "memory"); \
      else asm volatile("s_waitcnt vmcnt(0)" ::: "memory"); \
      __builtin_amdgcn_s_barrier(); \
      ks = (ks == 2) ? 0 : ks + 1; \
      vs = (vs + 1) & 3; \
    }
    if (fastsm) { ATT_LOOP(true) } else { ATT_LOOP(false) }
#undef ATT_LOOP
#undef ATT_COMPUTE
    if (map == 1) { const int vsp = (vs + 3) & 3; PV(vsp); }
    __syncthreads();
#undef DMA_TILE
#undef QK_SOFTMAX
#undef PV
    const float ltot = l_run + shx(l_run, 32, lane);
    const float inv = 1.f / ltot;
    float* X = (float*)shm;
    const int q = qsub * 32 + r;
    if (map == 1) {
#pragma unroll
      for (int d = 0; d < 4; ++d)
#pragma unroll
        for (int g4 = 0; g4 < 4; ++g4) {
          float4 o; o.x = O[d][g4 * 4 + 0] * inv; o.y = O[d][g4 * 4 + 1] * inv; o.z = O[d][g4 * 4 + 2] * inv; o.w = O[d][g4 * 4 + 3] * inv;
          *(float4*)(X + q * 132 + d * 32 + g4 * 8 + hh * 4) = o;
        }
    }
    __syncthreads();
    if (map == 0) {
      float ss = 0.f;
#pragma unroll
      for (int d = 0; d < 4; ++d)
#pragma unroll
        for (int g4 = 0; g4 < 4; ++g4) {
          float4 x2 = *(const float4*)(X + q * 132 + d * 32 + g4 * 8 + hh * 4);
          float o0 = O[d][g4 * 4 + 0] * inv - lam * x2.x, o1 = O[d][g4 * 4 + 1] * inv - lam * x2.y;
          float o2 = O[d][g4 * 4 + 2] * inv - lam * x2.z, o3 = O[d][g4 * 4 + 3] * inv - lam * x2.w;
          O[d][g4 * 4 + 0] = o0; O[d][g4 * 4 + 1] = o1; O[d][g4 * 4 + 2] = o2; O[d][g4 * 4 + 3] = o3;
          ss += o0 * o0 + o1 * o1 + o2 * o2 + o3 * o3;
        }
      ss += shx(ss, 32, lane);
      const float rinv = rsqrtf(ss * (1.f / 128.f) + 1e-6f) * (1.f - lam_init);
      unsigned char* os = shm + 67584 + q * 272;
#pragma unroll
      for (int d = 0; d < 4; ++d)
#pragma unroll
        for (int g4 = 0; g4 < 4; ++g4) {
          const int dv = d * 32 + g4 * 8 + hh * 4;
          float4 gh = *(const float4*)(ghead + dv);
          uint2 o; o.x = pack2(O[d][g4 * 4 + 0] * rinv * gh.x, O[d][g4 * 4 + 1] * rinv * gh.y);
          o.y = pack2(O[d][g4 * 4 + 2] * rinv * gh.z, O[d][g4 * 4 + 3] * rinv * gh.w);
          *(uint2*)(os + dv * 2) = o;
        }
    }
    asm volatile("s_waitcnt lgkmcnt(0)" ::: "memory");
    __builtin_amdgcn_s_barrier();
    {
      u16* ob = OB + (size_t)qrow0 * 1024 + head * 128;
#pragma unroll
      for (int i = 0; i < 4; ++i) {
        const int c = tid + 512 * i, row = c >> 4, c16 = c & 15;
        const uint4 v = *(const uint4*)(shm + 67584 + row * 272 + c16 * 16);
        *(uint4*)(ob + (size_t)row * 1024 + c16 * 8) = v;
      }
    }
    asm volatile("s_waitcnt lgkmcnt(0)" ::: "memory");
    __builtin_amdgcn_s_barrier();
  }
  __builtin_amdgcn_s_setprio(0);
}

DI float gelu_tanh(float y) {
  const float z = 0.7978845608028654f * (y + 0.044715f * y * y * y);
  const float t = 1.f - 2.f / (__expf(2.f * z) + 1.f);
  return 0.5f * y * (1.f + t);
}
DI int ssm_tok(int d, int b, int tau) {
  if (d == 0) return tau < 256 ? (NX + b * 256 + tau) : (b * 2048 + tau - 256);
  return tau < 256 ? (NX + b * 256 + 255 - tau) : (b * 2048 + 2047 - (tau - 256));
}
DI void phase_scan(const Params& p, int j, unsigned char* shm, int wv) {
  const int tid = ltid(wv), lane = tid & 63, w = tid >> 6;
  unsigned char* wl = shm + w * 12800;
  float* bu = (float*)wl;
  u16* Hl = (u16*)(wl + 8448);
  u16* BbT = (u16*)wl;
  const u16* ZS = (const u16*)(p.ws + R_ZS);
  const int col = lane & 15, quad = lane >> 4;
  for (int wg = blockIdx.x; wg < 256; wg += gridDim.x) {
    const int wt = wg * 8 + w;
    const int d = wt & 1, g = (wt >> 1) & 31, b = wt >> 6;
    const int dg = (j * 2 + d) * 32 + g;
    const int pst = lane;
    float abr, abi;
    {
      const float are = p.in[12][dg * 64 + pst], aim = p.in[13][dg * 64 + pst];
      const float dt = expf(p.in[14][dg]);
      const float er = expf(are * dt), ang = aim * dt;
      abr = er * cosf(ang); abi = er * sinf(ang);
      const float nr = abr - 1.f, ni = abi, den = are * are + aim * aim;
      const float cr = (nr * are + ni * aim) / den, ci = (ni * are - nr * aim) / den;
      const float* bre = p.in[15] + ((size_t)dg * 64 + pst) * 16;
      const float* bim = p.in[16] + ((size_t)dg * 64 + pst) * 16;
      __builtin_amdgcn_wave_barrier();
#pragma unroll
      for (int h = 0; h < 16; h += 2) {
        float br0 = bre[h], bi0 = bim[h], br1 = bre[h + 1], bi1 = bim[h + 1];
        *(unsigned*)(BbT + (2 * pst) * 16 + h) = pack2(cr * br0 - ci * bi0, cr * br1 - ci * bi1);
        *(unsigned*)(BbT + (2 * pst + 1) * 16 + h) = pack2(cr * bi0 + ci * br0, cr * bi1 + ci * br1);
      }
      __builtin_amdgcn_wave_barrier();
    }
    s16x4 bop[8];
#pragma unroll
    for (int nb = 0; nb < 8; ++nb) bop[nb] = *(const s16x4*)(BbT + (nb * 16 + col) * 16 + quad * 4);
    bf16x8 cop[4];
    {
      const float* cre = p.in[17] + ((size_t)dg * 16 + col) * 64;
      const float* cim = p.in[18] + ((size_t)dg * 16 + col) * 64;
#pragma unroll
      for (int kb = 0; kb < 4; ++kb) {
        float4 a = *(const float4*)(cre + kb * 16 + quad * 4), c = *(const float4*)(cim + kb * 16 + quad * 4);
        uint4 u = make_uint4(pack2(a.x, -c.x), pack2(a.y, -c.y), pack2(a.z, -c.z), pack2(a.w, -c.w));
        cop[kb] = __builtin_bit_cast(bf16x8, u);
      }
    }
    __builtin_amdgcn_wave_barrier();
    u16* Rd = (u16*)(p.ws + (d ? R_R1 : R_R0));
    float hr = 0.f, hi = 0.f;
    s16x4 ua = *(const s16x4*)(ZS + (size_t)ssm_tok(d, b, col) * 512 + g * 16 + quad * 4);
    s16x4 ub = *(const s16x4*)(ZS + (size_t)ssm_tok(d, b, 16 + col) * 512 + g * 16 + quad * 4);
    for (int c = 0; c < 144; ++c) {
      const int tau0 = c * 16;
      s16x4 ucur = ua;
      ua = ub;
      if (c + 2 < 144) ub = *(const s16x4*)(ZS + (size_t)ssm_tok(d, b, tau0 + 32 + col) * 512 + g * 16 + quad * 4);
#pragma unroll
      for (int nb = 0; nb < 8; ++nb) {
        f32x4 z = {0.f, 0.f, 0.f, 0.f};
        f32x4 r4 = __builtin_amdgcn_mfma_f32_16x16x16bf16_1k(ucur, bop[nb], z, 0, 0, 0);
#pragma unroll
        for (int jj = 0; jj < 4; ++jj) bu[(quad * 4 + jj) * 132 + nb * 16 + col] = r4[jj];
      }
      __builtin_amdgcn_wave_barrier();
      float2 bv[16];
#pragma unroll
      for (int t = 0; t < 16; ++t) bv[t] = *(const float2*)(bu + t * 132 + 2 * pst);
#pragma unroll
      for (int t = 0; t < 16; ++t) {
        const float nr = abr * hr - abi * hi + bv[t].x;
        const float ni = abr * hi + abi * hr + bv[t].y;
        hr = nr; hi = ni;
        *(unsigned*)(Hl + t * 136 + 2 * pst) = pack2(hr, hi);
      }
      __builtin_amdgcn_wave_barrier();
      f32x4 y = {0.f, 0.f, 0.f, 0.f};
#pragma unroll
      for (int kb = 0; kb < 4; ++kb) {
        bf16x8 af = *(const bf16x8*)(Hl + col * 136 + kb * 32 + quad * 8);
        y = __builtin_amdgcn_mfma_f32_16x16x32_bf16(cop[kb], af, y, 0, 0, 0);
      }
      {
        const int tok = ssm_tok(d, b, tau0 + col);
        uint2 o; o.x = pack2(y[0], y[1]); o.y = pack2(y[2], y[3]);
        *(uint2*)(Rd + (size_t)tok * 512 + g * 16 + quad * 4) = o;
      }
      __builtin_amdgcn_wave_barrier();
    }
    __syncthreads();
    __builtin_amdgcn_fence(__ATOMIC_ACQUIRE, "agent");
    {
      const u16* R0 = (const u16*)(p.ws + R_R0);
      const u16* R1 = (const u16*)(p.ws + R_R1);
      u16* YS = (u16*)(p.ws + R_YS);
      const int bb = wg >> 3, c0 = (wg & 7) * 64;
      const int c8 = c0 + (tid & 7) * 8;
      const float* dsk = p.in[19] + j * 512 + c8;
      const float4 d0 = *(const float4*)dsk, d1 = *(const float4*)(dsk + 4);
      for (int t0 = tid >> 3; t0 < 2304; t0 += 256) {
        uint4 u[4], a[4], bq[4]; size_t off[4];
#pragma unroll
        for (int q = 0; q < 4; ++q) {
          const int t = t0 + 64 * q;
          const int tok = (t < 2048) ? (bb * 2048 + t) : (NX + bb * 256 + (t - 2048));
          off[q] = (size_t)tok * 512 + c8;
          u[q] = *(const uint4*)(ZS + off[q]); a[q] = *(const uint4*)(R0 + off[q]); bq[q] = *(const uint4*)(R1 + off[q]);
        }
#pragma unroll
        for (int q = 0; q < 4; ++q) {
          float y0 = gelu_tanh(bflo(u[q].x) * d0.x + bflo(a[q].x) + bflo(bq[q].x)), y1 = gelu_tanh(bfhi(u[q].x) * d0.y + bfhi(a[q].x) + bfhi(bq[q].x));
          float y2 = gelu_tanh(bflo(u[q].y) * d0.z + bflo(a[q].y) + bflo(bq[q].y)), y3 = gelu_tanh(bfhi(u[q].y) * d0.w + bfhi(a[q].y) + bfhi(bq[q].y));
          float y4 = gelu_tanh(bflo(u[q].z) * d1.x + bflo(a[q].z) + bflo(bq[q].z)), y5 = gelu_tanh(bfhi(u[q].z) * d1.y + bfhi(a[q].z) + bfhi(bq[q].z));
          float y6 = gelu_tanh(bflo(u[q].w) * d1.z + bflo(a[q].w) + bflo(bq[q].w)), y7 = gelu_tanh(bfhi(u[q].w) * d1.w + bfhi(a[q].w) + bfhi(bq[q].w));
          uint4 o; o.x = pack2(y0, y1); o.y = pack2(y2, y3); o.z = pack2(y4, y5); o.w = pack2(y6, y7);
          *(uint4*)(YS + off[q]) = o;
        }
      }
    }
    __syncthreads();
  }
}

DI void phase_combine(const Params& p, int j, int wv) {
  const u16* ZS = (const u16*)(p.ws + R_ZS);
  const u16* R0 = (const u16*)(p.ws + R_R0);
  const u16* R1 = (const u16*)(p.ws + R_R1);
  u16* YS = (u16*)(p.ws + R_YS);
  const float* dsk = p.in[19] + j * 512;
  const int gt = blockIdx.x * 512 + ltid(wv), nth = gridDim.x * 512;
  for (int idx = gt; idx < NT * 64; idx += nth) {
    const int c8 = (idx & 63) * 8;
    const size_t off = (size_t)idx * 8;
    uint4 u = *(const uint4*)(ZS + off), a = *(const uint4*)(R0 + off), b = *(const uint4*)(R1 + off);
    float4 d0 = *(const float4*)(dsk + c8), d1 = *(const float4*)(dsk + c8 + 4);
    float y0 = gelu_tanh(bflo(u.x) * d0.x + bflo(a.x) + bflo(b.x)), y1 = gelu_tanh(bfhi(u.x) * d0.y + bfhi(a.x) + bfhi(b.x));
    float y2 = gelu_tanh(bflo(u.y) * d0.z + bflo(a.y) + bflo(b.y)), y3 = gelu_tanh(bfhi(u.y) * d0.w + bfhi(a.y) + bfhi(b.y));
    float y4 = gelu_tanh(bflo(u.z) * d1.x + bflo(a.z) + bflo(b.z)), y5 = gelu_tanh(bfhi(u.z) * d1.y + bfhi(a.z) + bfhi(b.z));
    float y6 = gelu_tanh(bflo(u.w) * d1.z + bflo(a.w) + bflo(b.w)), y7 = gelu_tanh(bfhi(u.w) * d1.w + bfhi(a.w) + bfhi(b.w));
    uint4 o; o.x = pack2(y0, y1); o.y = pack2(y2, y3); o.z = pack2(y4, y5); o.w = pack2(y6, y7);
    *(uint4*)(YS + off) = o;
  }
}

#define XB_TMO      128
#define XB_XCNT(j)  (256  + 64 * (j))
#define XB_XSUB(j)  (1280 + 64 * (j))
#define XB_XGEN(j)  (2304 + 64 * (j))
#define XB_TOP      3328
#define XB_TOPGEN   3392
#define XCD_BAR_WORDS 3456
#define XB_SPIN_CAP (1u << 18)
#define LAS __attribute__((address_space(3)))
__device__ __forceinline__ unsigned xb_ld(unsigned* p)              { return __hip_atomic_load(p, __ATOMIC_RELAXED, __HIP_MEMORY_SCOPE_AGENT); }
__device__ __forceinline__ unsigned xb_add(unsigned* p, unsigned v) { return __hip_atomic_fetch_add(p, v, __ATOMIC_RELAXED, __HIP_MEMORY_SCOPE_AGENT); }
__device__ __forceinline__ unsigned xb_xcc_id() { return (unsigned)__builtin_amdgcn_s_getreg((3 << 11) | 20) & 0xFu; }
#define XB_SPIN(cond, bar) do { unsigned _sp = 0; while (cond) { __builtin_amdgcn_s_sleep(1); \
    if ((++_sp & 255u) == 0u) { if (xb_ld(&(bar)[XB_TMO])) break; if (_sp > XB_SPIN_CAP) { atomicAdd(&(bar)[XB_TMO], 1u); break; } } } } while (0)
struct XcdBarrier { unsigned* bar; unsigned x; volatile LAS unsigned* st; };
__device__ __forceinline__ XcdBarrier xcd_barrier_post(unsigned* bar, volatile LAS unsigned* st) {
    XcdBarrier b; b.bar = bar; b.x = xb_xcc_id(); b.st = st;
    if (threadIdx.x == 0) (void)xb_add(&bar[XB_XCNT(b.x)], 1u);
    return b;
}
__device__ __forceinline__ void xcd_barrier_complete(unsigned* bar, unsigned x, unsigned& nloc, unsigned& nx) {
    const unsigned G = gridDim.x * gridDim.y * gridDim.z;
    unsigned sum, cnt, mine, sp = 0u;
    for (;;) {
        sum = 0u; cnt = 0u; mine = 0u;
#pragma unroll
        for (unsigned j = 0; j < 16; ++j) { const unsigned c = xb_ld(&bar[XB_XCNT(j)]); sum += c; cnt += (c > 0u) ? 1u : 0u; mine = (j == x) ? c : mine; }
        if (sum == G) break;
        __builtin_amdgcn_s_sleep(1);
        if ((++sp & 255u) == 0u) { if (xb_ld(&bar[XB_TMO])) break; if (sp > XB_SPIN_CAP) { atomicAdd(&bar[XB_TMO], 1u); break; } }
    }
    nloc = mine > 0u ? mine : 1u; nx = cnt > 0u ? cnt : 1u;
}
__device__ __forceinline__ void xcd_barrier(const XcdBarrier& b, int wv) {
    asm volatile("s_waitcnt vmcnt(0)" ::: "memory");
    __syncthreads();
    if (ltid(wv) == 0) {
        unsigned* bar = b.bar;
        unsigned bx = b.x; asm volatile("" : "+s"(bx));
        __builtin_amdgcn_s_waitcnt(0);
        unsigned nloc = b.st[0], nx = b.st[1];
        if (nloc == 0u) { xcd_barrier_complete(bar, bx, nloc, nx); b.st[0] = nloc; b.st[1] = nx; }
        const unsigned old = xb_add(&bar[XB_XSUB(bx)], 1u);
        const unsigned gen = old / nloc;
        if (old + 1u == (gen + 1u) * nloc) {
            __builtin_amdgcn_fence(__ATOMIC_RELEASE, "agent");
            asm volatile("s_waitcnt vmcnt(0)" ::: "memory");
            const unsigned og = xb_add(&bar[XB_TOP], 1u);
            const unsigned tg = og / nx;
            if (og + 1u == (tg + 1u) * nx) xb_add(&bar[XB_TOPGEN], 1u);
            else XB_SPIN(xb_ld(&bar[XB_TOPGEN]) == tg, bar);
            __builtin_amdgcn_fence(__ATOMIC_ACQUIRE, "agent");
            xb_add(&bar[XB_XGEN(bx)], 1u);
            asm volatile("s_waitcnt vmcnt(0)" ::: "memory");
        } else {
            XB_SPIN(xb_ld(&bar[XB_XGEN(bx)]) == gen, bar);
            __builtin_amdgcn_fence(__ATOMIC_ACQUIRE, "agent");
            asm volatile("s_waitcnt vmcnt(0)" ::: "memory");
        }
    }
    __syncthreads();
}

__global__ void __launch_bounds__(512) mega(Params p) {
  extern __shared__ __attribute__((aligned(16))) unsigned char shm[];
  cg::grid_group grid = cg::this_grid();
  unsigned char* ws = p.ws;
  u16* H = (u16*)(ws + OFF_H);
  float* CTXR = (float*)(ws + OFF_CTXR);
  const float* modv = (const float*)(ws + OFF_MODV);

  __shared__ uint4 xb_words;
  if (threadIdx.x == 0) xb_words = make_uint4(0u, 0u, 0u, 0u);
  __syncthreads();
  XcdBarrier xb; xb.bar = (unsigned*)(ws + OFF_BAR); xb.x = xb_xcc_id(); xb.st = (volatile LAS unsigned*)&xb_words;
  if (threadIdx.x == 0) xb_words.w = xb_add(&xb.bar[XB_XCNT(xb.x)], 1u);
  const int wv = __builtin_amdgcn_readfirstlane((int)(threadIdx.x >> 6));
  phase_prep(p, shm, wv);
  grid.sync();
  if (threadIdx.x == 0) {
    unsigned base = 0;
    for (unsigned jx = 0; jx < 16; ++jx) { const unsigned c = xb_ld(&xb.bar[XB_XCNT(jx)]); base += (jx < xb.x) ? c : 0u; }
    xb_words.z = base + xb_words.w;
  }
  __syncthreads();
  const int slot = __builtin_amdgcn_readfirstlane((int)xb_words.z);

  phase_sh(p, wv);
  phase_norm(p, 0, 1, p.in[0], p.in[2], NT, wv);
  xcd_barrier(xb, wv);
  {
    const int nbk = (int)gridDim.x;
    int off = 0;
    for (int q = 0; q < 8; ++q) {
      const int li = q >> 1, lj = li >> 1;
      Epi es{}; es.xo = (float*)(ws + OFF_SHW) + (size_t)q * 33 * 4096;
      const u16* Aq = (const u16*)(ws + OFF_SH) + (size_t)q * 256 * 1024;
      const u16* Bq; int Nq;
      if (q & 1) { Bq = (const u16*)(ws + OFF_W1T) + (size_t)li * 4096 * 1024; Nq = 4096; }
      else if ((li & 1) == 0) { Bq = (const u16*)(ws + OFF_EVIN) + (size_t)lj * 1536 * 1024; Nq = 1536; }
      else { Bq = (const u16*)(ws + OFF_ODIN) + (size_t)lj * 3072 * 1024; Nq = 3072; }
      const int sl = (slot + nbk - (off % nbk)) % nbk;
      gemm_phase<EPI_F32>(Aq, 1024, Bq, 1024, 256, Nq, 1024, es, shm, wv, sl);
      off += Nq / 256;
    }
  }
  xcd_barrier(xb, wv);
  const float* STATS = (const float*)(ws + OFF_STATS);
  const float* SHW = (const float*)(ws + OFF_SHW);

  for (int i = 0; i < 4; ++i) {
    const bool last = (i == 3);
    const int j = i >> 1;
    const float* xsrc = (i == 0) ? p.in[0] : p.out;
    const float* csrc = (i == 0) ? p.in[2] : CTXR;
    const float* st1 = (i == 0) ? nullptr : STATS;
    const float* shw1 = SHW + (size_t)(i * 2) * 33 * 4096;
    Epi e{};
    if ((i & 1) == 0) {
      e = Epi{}; e.o16 = (u16*)(ws + R_ABT); e.o16b = (u16*)(ws + R_ABTC); e.stats = st1; e.shw = shw1;
      gemm_phase<EPI_FT>((const u16*)(ws + OFF_EVIN) + (size_t)j * 1536 * 1024, 1024, H, 1024, 1024, NT, 1024, e, shm, wv, slot);
      e = Epi{}; e.o16 = (u16*)(ws + R_ZS); e.ldo = 512; e.stats = st1; e.shw = shw1 + 1024;
      gemm_phase<EPI_STORE>(H, 1024, (const u16*)(ws + OFF_EVIN) + (size_t)j * 1536 * 1024 + 1024 * 1024, 1024, NT, 512, 1024, e, shm, wv, (int)gridDim.x - 1 - slot);
      xcd_barrier(xb, wv);
      e = Epi{}; e.o16 = (u16*)(ws + R_MIX); e.rowbase = 0; e.L = 2048;
      gemm_phase<EPI_FOUT>((const u16*)(ws + OFF_F2048), 4096, (const u16*)(ws + R_ABT), 4096, 2048, 16384, 4096, e, shm, wv, slot);
      e = Epi{}; e.o16 = (u16*)(ws + R_MIX); e.rowbase = NX; e.L = 256;
      gemm_phase<EPI_FOUT>((const u16*)(ws + OFF_F256), 512, (const u16*)(ws + R_ABTC), 512, 256, 16384, 512, e, shm, wv, slot);
      __syncthreads();
      phase_scan(p, j, shm, wv);
      xcd_barrier(xb, wv);
      e = Epi{}; e.o16 = (u16*)(ws + R_MIX); e.a16 = (const u16*)(ws + R_YS); e.bias = p.in[21] + j * 512;
      gemm_phase<EPI_GLU>((const u16*)(ws + R_YS), 512, (const u16*)(ws + OFF_GLU) + (size_t)j * 512 * 512, 512, NT, 512, 512, e, shm, wv, slot);
      xcd_barrier(xb, wv);
      e = Epi{}; e.xo = p.out; e.co = CTXR; e.xi = xsrc; e.ci = csrc; e.gate = modv + (size_t)i * 33 * 6144 + 2 * 1024;
      e.hout = H; e.stats_out = (float*)(ws + OFF_STATS); e.ngain = p.in[5] + i * 1024; e.nscale = modv + (size_t)i * 33 * 6144 + 4 * 1024;
      gemm_phase<EPI_RESID>((const u16*)(ws + R_MIX), 1024, (const u16*)(ws + OFF_EVOUT) + (size_t)j * 1024 * 1024, 1024, NT, 1024, 1024, e, shm, wv, slot);
    } else {
      e = Epi{}; e.o16 = (u16*)(ws + R_QKB); e.ldo = 2048; e.stats = st1; e.shw = shw1;
      gemm_phase<EPI_STORE>(H, 1024, (const u16*)(ws + OFF_ODIN) + (size_t)j * 3072 * 1024, 1024, NT, 2048, 1024, e, shm, wv, slot);
      xcd_barrier(xb, wv);
      e = Epi{}; e.o16 = (u16*)(ws + R_VT); e.stats = st1; e.shw = shw1 + 2048;
      if (slot & 1) phase_qknorm(p, j, wv);
      gemm_phase<EPI_VT>((const u16*)(ws + OFF_ODIN) + (size_t)j * 3072 * 1024 + (size_t)2048 * 1024, 1024, H, 1024, 1024, NT, 1024, e, shm, wv, (int)gridDim.x - 1 - slot);
      if (!(slot & 1)) { __syncthreads(); phase_qknorm(p, j, wv); }
      xcd_barrier(xb, wv);
      const float lam_init = 0.8f - 0.6f * expf(-0.3f * (float)i);
      phase_attn(p, j, lam_init, last, shm, wv, slot);
      xcd_barrier(xb, wv);
      e = Epi{}; e.xo = p.out; e.co = CTXR; e.xi = xsrc; e.ci = csrc; e.gate = modv + (size_t)i * 33 * 6144 + 2 * 1024;
      e.hout = H; e.stats_out = (float*)(ws + OFF_STATS); e.ngain = p.in[5] + i * 1024; e.nscale = modv + (size_t)i * 33 * 6144 + 4 * 1024;
      gemm_phase<EPI_RESID>((const u16*)(ws + R_MIX), 1024, (const u16*)(ws + OFF_ODOUT) + (size_t)j * 1024 * 1024, 1024, last ? NX : NT, 1024, 1024, e, shm, wv, slot);
    }
    xcd_barrier(xb, wv);
    const int nrows = last ? NX : NT;
    e = Epi{}; e.o16 = (u16*)(ws + R_HID); e.ldo = 4096; e.stats = STATS; e.shw = SHW + (size_t)(i * 2 + 1) * 33 * 4096;
    gemm_phase<EPI_SQRELU>(H, 1024, (const u16*)(ws + OFF_W1T) + (size_t)i * 4096 * 1024, 1024, nrows, 4096, 1024, e, shm, wv, slot);
    xcd_barrier(xb, wv);
    e = Epi{}; e.xo = p.out; e.co = CTXR; e.xi = p.out; e.ci = CTXR; e.gate = modv + (size_t)i * 33 * 6144 + 5 * 1024;
    if (!last) { e.hout = H; e.stats_out = (float*)(ws + OFF_STATS); e.ngain = p.in[4] + (i + 1) * 1024; e.nscale = modv + (size_t)(i + 1) * 33 * 6144 + 1 * 1024; }
    gemm_phase<EPI_RESID>((const u16*)(ws + R_HID), 4096, (const u16*)(ws + OFF_W2T) + (size_t)i * 4096 * 1024, 4096, nrows, 1024, 4096, e, shm, wv, slot);
    xcd_barrier(xb, wv);
  }
}

extern "C" void kernel_launch(void* const* d_in, const int* in_sizes, int n_in,
                              void* d_out, int out_size, void* d_ws, size_t ws_size,
                              hipStream_t stream) {
  static int grid_blocks = 0;
  if (!grid_blocks) {
    int dev = 0, cus = 0, per_cu = 0;
    (void)hipGetDevice(&dev);
    (void)hipDeviceGetAttribute(&cus, hipDeviceAttributeMultiprocessorCount, dev);
    (void)hipFuncSetAttribute((const void*)mega, hipFuncAttributeMaxDynamicSharedMemorySize, LDS_BYTES);
    (void)hipOccupancyMaxActiveBlocksPerMultiprocessor(&per_cu, (const void*)mega, 512, LDS_BYTES);
    if (per_cu < 1) per_cu = 1;
    grid_blocks = cus * per_cu;
    if (n_in != 28 || ws_size < WS_END) { fprintf(stderr, "kernel_launch: bad shapes n_in=%d ws=%zu\n", n_in, ws_size); grid_blocks = -1; }
  }
  if (grid_blocks < 0) return;
  Params p{};
  for (int i = 0; i < 28; ++i) p.in[i] = (const float*)d_in[i];
  p.out = (float*)d_out;
  p.ws = (unsigned char*)d_ws;
  (void)hipMemsetAsync((unsigned char*)d_ws + OFF_BAR, 0, XCD_BAR_WORDS * sizeof(unsigned), stream);
  void* args[] = {&p};
  hipError_t e = hipLaunchCooperativeKernel((void*)mega, dim3(grid_blocks), dim3(512), args, LDS_BYTES, stream);
  if (e != hipSuccess) fprintf(stderr, "cooperative launch failed: %s\n", hipGetErrorString(e));
}
```

```cpp
#include <hip/hip_runtime.h>
#include <hip/hip_bf16.h>
#include <hip/hip_cooperative_groups.h>
#include <cstdio>
namespace cg = cooperative_groups;

#define DI __device__ __forceinline__
typedef unsigned short u16;
using bf16x8 = __attribute__((ext_vector_type(8))) short;
using s16x4 = __attribute__((ext_vector_type(4))) short;
using f32x4 = __attribute__((ext_vector_type(4))) float;
using f32x16 = __attribute__((ext_vector_type(16))) float;
typedef __bf16 bf16x2_t __attribute__((ext_vector_type(2)));
typedef float f32x2_t __attribute__((ext_vector_type(2)));

DI unsigned pack2(float a, float b) {
  f32x2_t v = {a, b};
  bf16x2_t r = __builtin_convertvector(v, bf16x2_t);
  return __builtin_bit_cast(unsigned, r);
}
DI float bflo(unsigned u) { return __uint_as_float(u << 16); }
DI float bfhi(unsigned u) { return __uint_as_float(u & 0xffff0000u); }
DI u16 f2bf(float x) { return (u16)(pack2(x, 0.f) & 0xffffu); }
DI float shx(float v, int o, int lane) { return __int_as_float(__builtin_amdgcn_ds_bpermute((lane ^ o) << 2, __float_as_int(v))); }
DI float wave_sum(float v, int lane) {
#pragma unroll
  for (int o = 32; o >= 1; o >>= 1) v += shx(v, o, lane);
  return v;
}

DI const char* uptr(const void* p) {
  unsigned long long v = (unsigned long long)p;
  unsigned lo = __builtin_amdgcn_readfirstlane((unsigned)v), hi = __builtin_amdgcn_readfirstlane((unsigned)(v >> 32));
  return (const char*)(((unsigned long long)hi << 32) | lo);
}
DI int ltid(int wv) { int l; asm volatile("v_mbcnt_lo_u32_b32 %0, -1, 0\n\tv_mbcnt_hi_u32_b32 %0, -1, %0" : "=v"(l)); return wv * 64 + l; }

constexpr int NX = 65536;
constexpr int NC = 8192;
constexpr int NT = NX + NC;
constexpr size_t MiB = 1ull << 20;
constexpr size_t OFF_W1T = 0, OFF_W2T = 32 * MiB, OFF_EVIN = 64 * MiB, OFF_EVOUT = 70 * MiB, OFF_GLU = 74 * MiB,
                 OFF_ODIN = 75 * MiB, OFF_ODOUT = 87 * MiB, OFF_F2048 = 91 * MiB, OFF_F256 = 107 * MiB,
                 OFF_MODV = 108 * MiB, OFF_BAR = 111 * MiB + 512 * 1024, OFF_CTXR = 112 * MiB, OFF_H = 144 * MiB, OFF_R = 288 * MiB,
                 OFF_STATS = 864 * MiB, OFF_SHW = 869 * MiB, OFF_SH = 874 * MiB, WS_END = 878 * MiB;
constexpr size_t R_ABT = OFF_R, R_ABTC = OFF_R + 128 * MiB, R_ZS = OFF_R + 144 * MiB, R_R0 = OFF_R + 216 * MiB,
                 R_R1 = OFF_R + 288 * MiB, R_YS = OFF_R + 360 * MiB, R_MIX = OFF_R + 432 * MiB;
constexpr size_t R_QKB = OFF_R, R_VT = OFF_R + 288 * MiB, R_HID = OFF_R;
constexpr int LDS_BYTES = 131072;

struct Params {
  const float* in[28];
  float* out;
  unsigned char* ws;
};

constexpr int BM = 256, BK = 64, HALF = 128, HT = HALF * BK;
enum { EPI_STORE = 0, EPI_SQRELU = 1, EPI_RESID = 2, EPI_GLU = 3, EPI_FOUT = 4, EPI_TRANS_F = 5, EPI_TRANS_V = 6, EPI_F32 = 7, EPI_FT = 8, EPI_VT = 9 };

struct Epi {
  u16* o16;
  u16* o16b;
  const u16* a16;
  float* xo;
  float* co;
  const float* xi;
  const float* ci;
  const float* gate;
  const float* bias;
  int ldo;
  int rowbase;
  int L;
  const float* stats;
  const float* shw;
  u16* hout;
  float* stats_out;
  const float* ngain;
  const float* nscale;
};
DI float row_rinv(const float* stats, int r) {
  const float ssum = (stats[r] + stats[NT + r]) + (stats[2 * NT + r] + stats[3 * NT + r]);
  return rsqrtf(ssum * (1.f / 1024.f) + 1e-6f);
}
DI f32x4 row_rinv4(const float* stats, int r) {
  float4 a = *(const float4*)(stats + r), b = *(const float4*)(stats + NT + r), c = *(const float4*)(stats + 2 * NT + r), d = *(const float4*)(stats + 3 * NT + r);
  f32x4 o;
  o[0] = rsqrtf(((a.x + b.x) + (c.x + d.x)) * (1.f / 1024.f) + 1e-6f); o[1] = rsqrtf(((a.y + b.y) + (c.y + d.y)) * (1.f / 1024.f) + 1e-6f);
  o[2] = rsqrtf(((a.z + b.z) + (c.z + d.z)) * (1.f / 1024.f) + 1e-6f); o[3] = rsqrtf(((a.w + b.w) + (c.w + d.w)) * (1.f / 1024.f) + 1e-6f);
  return o;
}

DI int lds_byte(int r, int c) {
  int st = (r >> 4) * 2 + (c >> 5), rr = r & 15, cc = c & 31, ob = rr * 64 + cc * 2;
  return st * 1024 + (ob ^ (((ob >> 9) & 1) << 5));
}
DI void stage_rc(int b, int& R, int& C) {
  int st = b / 1024, sb = b % 1024, swz = sb ^ (((sb >> 9) & 1) << 5);
  R = (st >> 1) * 16 + swz / 64; C = (st & 1) * 32 + (swz % 64) / 2;
}

template <int EPI>
DI void epi4(const Epi& e, int r, int c, f32x4 v, f32x4 rinv4, float shv) {
  if constexpr (EPI == EPI_TRANS_F || EPI == EPI_TRANS_V) {
    if (e.stats) { v[0] = v[0] * rinv4[0] + shv; v[1] = v[1] * rinv4[1] + shv; v[2] = v[2] * rinv4[2] + shv; v[3] = v[3] * rinv4[3] + shv; }
  }
  if constexpr (EPI == EPI_STORE) {
    uint2 o; o.x = pack2(v[0], v[1]); o.y = pack2(v[2], v[3]);
    *(uint2*)(e.o16 + (size_t)r * e.ldo + c) = o;
  } else if constexpr (EPI == EPI_SQRELU) {
    float a0 = fmaxf(v[0], 0.f), a1 = fmaxf(v[1], 0.f), a2 = fmaxf(v[2], 0.f), a3 = fmaxf(v[3], 0.f);
    uint2 o; o.x = pack2(a0 * a0, a1 * a1); o.y = pack2(a2 * a2, a3 * a3);
    *(uint2*)(e.o16 + (size_t)r * e.ldo + c) = o;
  } else if constexpr (EPI == EPI_RESID) {
    const float* src; float* dst; int mrow;
    if (r < NX) { src = e.xi + (size_t)r * 1024 + c; dst = e.xo + (size_t)r * 1024 + c; mrow = r >> 11; }
    else { int rc = r - NX; src = e.ci + (size_t)rc * 1024 + c; dst = e.co + (size_t)rc * 1024 + c; mrow = 32; }
    float4 g = *(const float4*)(e.gate + (size_t)mrow * 6144 + c);
    float4 s = *(const float4*)src;
    float4 o; o.x = s.x + g.x * v[0]; o.y = s.y + g.y * v[1]; o.z = s.z + g.z * v[2]; o.w = s.w + g.w * v[3];
    *(float4*)dst = o;
  } else if constexpr (EPI == EPI_GLU) {
    uint2 y = *(const uint2*)(e.a16 + (size_t)r * 512 + c);
    float4 b = *(const float4*)(e.bias + c);
    float y0 = bflo(y.x), y1 = bfhi(y.x), y2 = bflo(y.y), y3 = bfhi(y.y);
    float s0 = 1.f / (1.f + __expf(-(v[0] + b.x))), s1 = 1.f / (1.f + __expf(-(v[1] + b.y)));
    float s2 = 1.f / (1.f + __expf(-(v[2] + b.z))), s3 = 1.f / (1.f + __expf(-(v[3] + b.w)));
    uint2 o; o.x = pack2(y0 * s0, y1 * s1); o.y = pack2(y2 * s2, y3 * s3);
    *(uint2*)(e.o16 + (size_t)r * 1024 + 512 + c) = o;
  } else if constexpr (EPI == EPI_FOUT) {
    int b = c >> 9, cc = c & 511;
    uint2 o; o.x = pack2(v[0], v[1]); o.y = pack2(v[2], v[3]);
    *(uint2*)(e.o16 + ((size_t)e.rowbase + (size_t)b * e.L + r) * 1024 + cc) = o;
  } else if constexpr (EPI == EPI_TRANS_F) {
    int part = c >> 9, jj = c & 511;
    uint2 o; o.x = pack2(v[0], v[1]); o.y = pack2(v[2], v[3]);
    if (r < NX) { int b = r >> 11, l = r & 2047; *(uint2*)(e.o16 + ((size_t)(b * 512 + jj)) * 4096 + part * 2048 + l) = o; }
    else { int rc = r - NX; int b = rc >> 8, l = rc & 255; *(uint2*)(e.o16b + ((size_t)(b * 512 + jj)) * 512 + part * 256 + l) = o; }
  } else if constexpr (EPI == EPI_TRANS_V) {
    uint2 o; o.x = pack2(v[0], v[1]); o.y = pack2(v[2], v[3]);
    int b, pos;
    if (r < NX) { b = r >> 11; pos = r & 2047; } else { int rc = r - NX; b = rc >> 8; pos = 2048 + (rc & 255); }
    pos = (pos & ~12) | ((pos & 4) << 1) | ((pos & 8) >> 1);
    *(uint2*)(e.o16 + ((size_t)(b * 1024 + c)) * 2304 + pos) = o;
  }
}

template <int EPI>
DI float epi8(const Epi& e, int r, int c, f32x4 v0, f32x4 v1, float rinv, float4 s0, float4 s1, float4 t0, float4 t1) {
  if constexpr (EPI == EPI_STORE || EPI == EPI_SQRELU) {
    if (e.stats) {
      v0[0] = v0[0] * rinv + s0.x; v0[1] = v0[1] * rinv + s0.y; v0[2] = v0[2] * rinv + s0.z; v0[3] = v0[3] * rinv + s0.w;
      v1[0] = v1[0] * rinv + s1.x; v1[1] = v1[1] * rinv + s1.y; v1[2] = v1[2] * rinv + s1.z; v1[3] = v1[3] * rinv + s1.w;
    }
  }
  if constexpr (EPI == EPI_F32) {
    if (r < 33) {
      float* d = e.xo + (size_t)r * 4096 + c;
      *(float4*)d = make_float4(v0[0], v0[1], v0[2], v0[3]); *(float4*)(d + 4) = make_float4(v1[0], v1[1], v1[2], v1[3]);
    }
  }
  if constexpr (EPI == EPI_STORE) {
    uint4 o; o.x = pack2(v0[0], v0[1]); o.y = pack2(v0[2], v0[3]); o.z = pack2(v1[0], v1[1]); o.w = pack2(v1[2], v1[3]);
    *(uint4*)(e.o16 + (size_t)r * e.ldo + c) = o;
  } else if constexpr (EPI == EPI_SQRELU) {
    float a0 = fmaxf(v0[0], 0.f), a1 = fmaxf(v0[1], 0.f), a2 = fmaxf(v0[2], 0.f), a3 = fmaxf(v0[3], 0.f);
    float a4 = fmaxf(v1[0], 0.f), a5 = fmaxf(v1[1], 0.f), a6 = fmaxf(v1[2], 0.f), a7 = fmaxf(v1[3], 0.f);
    uint4 o; o.x = pack2(a0 * a0, a1 * a1); o.y = pack2(a2 * a2, a3 * a3); o.z = pack2(a4 * a4, a5 * a5); o.w = pack2(a6 * a6, a7 * a7);
    *(uint4*)(e.o16 + (size_t)r * e.ldo + c) = o;
  } else if constexpr (EPI == EPI_RESID) {
    const float* src; float* dst;
    if (r < NX) { src = e.xi + (size_t)r * 1024 + c; dst = e.xo + (size_t)r * 1024 + c; }
    else { int rc = r - NX; src = e.ci + (size_t)rc * 1024 + c; dst = e.co + (size_t)rc * 1024 + c; }
    float4 x0 = *(const float4*)src, x1 = *(const float4*)(src + 4);
    float4 o0, o1;
    o0.x = x0.x + s0.x * v0[0]; o0.y = x0.y + s0.y * v0[1]; o0.z = x0.z + s0.z * v0[2]; o0.w = x0.w + s0.w * v0[3];
    o1.x = x1.x + s1.x * v1[0]; o1.y = x1.y + s1.y * v1[1]; o1.z = x1.z + s1.z * v1[2]; o1.w = x1.w + s1.w * v1[3];
    *(float4*)dst = o0; *(float4*)(dst + 4) = o1;
    if (e.hout) {
      uint4 h;
      h.x = pack2(o0.x * t0.x, o0.y * t0.y); h.y = pack2(o0.z * t0.z, o0.w * t0.w);
      h.z = pack2(o1.x * t1.x, o1.y * t1.y); h.w = pack2(o1.z * t1.z, o1.w * t1.w);
      *(uint4*)(e.hout + (size_t)r * 1024 + c) = h;
      return (o0.x * o0.x + o0.y * o0.y) + (o0.z * o0.z + o0.w * o0.w) + (o1.x * o1.x + o1.y * o1.y) + (o1.z * o1.z + o1.w * o1.w);
    }
  } else if constexpr (EPI == EPI_GLU) {
    uint4 y = *(const uint4*)(e.a16 + (size_t)r * 512 + c);
    float g0 = 1.f / (1.f + __expf(-(v0[0] + s0.x))), g1 = 1.f / (1.f + __expf(-(v0[1] + s0.y)));
    float g2 = 1.f / (1.f + __expf(-(v0[2] + s0.z))), g3 = 1.f / (1.f + __expf(-(v0[3] + s0.w)));
    float g4 = 1.f / (1.f + __expf(-(v1[0] + s1.x))), g5 = 1.f / (1.f + __expf(-(v1[1] + s1.y)));
    float g6 = 1.f / (1.f + __expf(-(v1[2] + s1.z))), g7 = 1.f / (1.f + __expf(-(v1[3] + s1.w)));
    uint4 o; o.x = pack2(bflo(y.x) * g0, bfhi(y.x) * g1); o.y = pack2(bflo(y.y) * g2, bfhi(y.y) * g3);
    o.z = pack2(bflo(y.z) * g4, bfhi(y.z) * g5); o.w = pack2(bflo(y.w) * g6, bfhi(y.w) * g7);
    *(uint4*)(e.o16 + (size_t)r * 1024 + 512 + c) = o;
  } else if constexpr (EPI == EPI_FT || EPI == EPI_VT) {
    if (e.stats) {
      v0[0] = v0[0] * s0.x + rinv; v0[1] = v0[1] * s0.y + rinv; v0[2] = v0[2] * s0.z + rinv; v0[3] = v0[3] * s0.w + rinv;
      v1[0] = v1[0] * s1.x + rinv; v1[1] = v1[1] * s1.y + rinv; v1[2] = v1[2] * s1.z + rinv; v1[3] = v1[3] * s1.w + rinv;
    }
    int b, pos;
    if (c < NX) { b = c >> 11; pos = c & 2047; } else { const int rc = c - NX; b = rc >> 8; pos = rc & 255; }
    if constexpr (EPI == EPI_FT) {
      const int part = r >> 9, jj = r & 511;
      uint4 o; o.x = pack2(v0[0], v0[1]); o.y = pack2(v0[2], v0[3]); o.z = pack2(v1[0], v1[1]); o.w = pack2(v1[2], v1[3]);
      if (c < NX) *(uint4*)(e.o16 + ((size_t)(b * 512 + jj)) * 4096 + part * 2048 + pos) = o;
      else *(uint4*)(e.o16b + ((size_t)(b * 512 + jj)) * 512 + part * 256 + pos) = o;
    } else {
      if (c >= NX) pos += 2048;
      const int p0 = (pos & ~12) | ((pos & 4) << 1) | ((pos & 8) >> 1);
      const int q1 = pos + 4, p1 = (q1 & ~12) | ((q1 & 4) << 1) | ((q1 & 8) >> 1);
      u16* dst = e.o16 + ((size_t)(b * 1024 + r)) * 2304;
      uint2 oa; oa.x = pack2(v0[0], v0[1]); oa.y = pack2(v0[2], v0[3]);
      uint2 ob; ob.x = pack2(v1[0], v1[1]); ob.y = pack2(v1[2], v1[3]);
      *(uint2*)(dst + p0) = oa; *(uint2*)(dst + p1) = ob;
    }
  } else if constexpr (EPI == EPI_FOUT) {
    int b = c >> 9, cc = c & 511;
    uint4 o; o.x = pack2(v0[0], v0[1]); o.y = pack2(v0[2], v0[3]); o.z = pack2(v1[0], v1[1]); o.w = pack2(v1[2], v1[3]);
    *(uint4*)(e.o16 + ((size_t)e.rowbase + (size_t)b * e.L + r) * 1024 + cc) = o;
  }
  return 0.f;
}

DI int gemm_decode(int T, int nsuper, int nNs, int SWM, int SWN, int nM, int& pm, int& pn) {
  const int sup = T >> 5, within = T & 31;
  if (sup >= nsuper) return -1;
  const int mg = sup / nNs, ng = sup - mg * nNs;
  pm = mg * SWM + within / SWN; pn = ng * SWN + within % SWN;
  return pm < nM ? 1 : 0;
}

template <int EPI>
DI void gemm_phase(const u16* __restrict__ A, int lda, const u16* __restrict__ Bt, int ldb,
                   int M, int N, int K, const Epi& e, unsigned char* shmraw, int wv, int slot) {
  constexpr bool SWAP = (EPI != EPI_TRANS_F && EPI != EPI_TRANS_V);
  u16* shm = (u16*)shmraw;
  const int tidx = ltid(wv);
#define SA(b, h) (shm + ((b) * 2 + (h)) * HT)
#define SB(b, h) (shm + (4 + (b) * 2 + (h)) * HT)
#define STAGEA(P, br, kt) do { const char* _g = uptr(A + (size_t)(br) * lda + (size_t)(kt) * BK); \
    _Pragma("unroll") for (int _i = 0; _i < 2; ++_i) { \
      __builtin_amdgcn_global_load_lds((const unsigned*)(_g + offA[_i]), (unsigned*)((char*)(P) + tidx * 16 + _i * 8192), 16, 0, 0); } } while (0)
#define STAGEB(P, br, kt) do { const char* _g = uptr(Bt + (size_t)(br) * ldb + (size_t)(kt) * BK); \
    _Pragma("unroll") for (int _i = 0; _i < 2; ++_i) { \
      __builtin_amdgcn_global_load_lds((const unsigned*)(_g + offB[_i]), (unsigned*)((char*)(P) + tidx * 16 + _i * 8192), 16, 0, 0); } } while (0)
#define LDA(dst, b, h) _Pragma("unroll") for (int m = 0; m < 4; ++m) _Pragma("unroll") for (int k = 0; k < 2; ++k) \
    dst[m][k] = *reinterpret_cast<const bf16x8*>((char*)SA(b, h) + aoff + m * 2048 + k * 1024)
#define LDB(dst, b, h) _Pragma("unroll") for (int n = 0; n < 2; ++n) _Pragma("unroll") for (int k = 0; k < 2; ++k) \
    dst[n][k] = *reinterpret_cast<const bf16x8*>((char*)SB(b, h) + boff + n * (SWAP ? 256 : 2048) + k * 1024)
#define MMA(ai, bj, AT, BT) do { __builtin_amdgcn_s_setprio(1); \
    _Pragma("unroll") for (int m = 0; m < 4; ++m) _Pragma("unroll") for (int n = 0; n < 2; ++n) _Pragma("unroll") for (int k = 0; k < 2; ++k) { \
      if constexpr (SWAP) acc[ai][bj][m][n] = __builtin_amdgcn_mfma_f32_16x16x32_bf16(BT[n][k], AT[m][k], acc[ai][bj][m][n], 0, 0, 0); \
      else acc[ai][bj][m][n] = __builtin_amdgcn_mfma_f32_16x16x32_bf16(AT[m][k], BT[n][k], acc[ai][bj][m][n], 0, 0, 0); } \
    __builtin_amdgcn_s_setprio(0); } while (0)
#define WAIT_V(n) asm volatile("s_waitcnt vmcnt(" #n ")" ::: "memory")
#define WAIT_L(n) asm volatile("s_waitcnt lgkmcnt(" #n ")" ::: "memory")
#define BAR __builtin_amdgcn_s_barrier()
#define SCHED __builtin_amdgcn_sched_barrier(0)

  const int nM = M / BM, nN = N / BM;
  int SWN = nN < 4 ? nN : 4, SWM = 32 / SWN;
  if (nM < 8) { SWM = 1; SWN = nN < 32 ? nN : 32; }
  if (nM == 4 && (nN & 7) == 0) { SWM = 4; SWN = 8; }
  const int nNs = nN / SWN, nMs = (nM + SWM - 1) / SWM;
  const int nsuper = nNs * nMs;
  const int nb = gridDim.x;
  const int wid = tidx >> 6, lane = tidx & 63, wr = wid >> 2, wc = wid & 3, fr = lane & 15, fq = lane >> 4;
  const int aoff = lds_byte(wr * 64 + fr, fq * 8);
  const int boff = lds_byte(wc * 32 + (SWAP ? ((fr >> 2) * 8 + (fr & 3)) : fr), fq * 8);
  unsigned offA[2], offB[2];
#pragma unroll
  for (int i = 0; i < 2; ++i) { int r_, c_; stage_rc(tidx * 16 + i * 8192, r_, c_); offA[i] = (unsigned)(r_ * lda + c_) * 2u; offB[i] = (unsigned)(r_ * ldb + c_) * 2u; }
  const int nt = K / BK;

  int T = slot, pm = 0, pn = 0, st_;
  while ((st_ = gemm_decode(T, nsuper, nNs, SWM, SWN, nM, pm, pn)) == 0) T += nb;
  if (st_ < 0) return;
#define PROLOGUE_STAGES(br_, bc_) do { \
    STAGEB(SB(0, 0), bc_, 0); STAGEA(SA(0, 0), br_, 0); STAGEB(SB(0, 1), (bc_) + HALF, 0); STAGEA(SA(0, 1), (br_) + HALF, 0); \
    STAGEB(SB(1, 0), bc_, 1); STAGEA(SA(1, 0), br_, 1); STAGEB(SB(1, 1), (bc_) + HALF, 1); } while (0)
  PROLOGUE_STAGES(pm * BM, pn * BM);
  bool first_tile = true;
  for (;;) {
    const int brow = pm * BM, bcol = pn * BM;
    int pm2 = 0, pn2 = 0, st2;
    T += nb;
    while ((st2 = gemm_decode(T, nsuper, nNs, SWM, SWN, nM, pm2, pn2)) == 0) T += nb;
    f32x4 acc[2][2][4][2];
#pragma unroll
    for (int a = 0; a < 2; ++a)
#pragma unroll
      for (int b = 0; b < 2; ++b)
#pragma unroll
        for (int m = 0; m < 4; ++m)
#pragma unroll
          for (int n = 0; n < 2; ++n) acc[a][b][m][n] = f32x4{0.f, 0.f, 0.f, 0.f};
    bf16x8 At[4][2], B0[2][2], B1[2][2];
    if (first_tile) WAIT_V(0);
    else if constexpr (EPI == EPI_STORE || EPI == EPI_SQRELU || EPI == EPI_GLU || EPI == EPI_FOUT || EPI == EPI_FT) WAIT_V(16);
    else if constexpr (EPI == EPI_TRANS_F || EPI == EPI_TRANS_V || EPI == EPI_VT) WAIT_V(32);
    else if constexpr (EPI == EPI_RESID) { if (e.hout) WAIT_V(48); else WAIT_V(32); }
    else WAIT_V(0);
    first_tile = false;
    if (wr == 1) BAR;
    BAR;
    for (int t = 0; t < nt - 2; t += 2) {
      LDB(B0, 0, 0); SCHED; LDA(At, 0, 0); STAGEA(SA(1, 1), brow + HALF, t + 1);
      WAIT_L(8); BAR; WAIT_L(0); MMA(0, 0, At, B0); BAR; SCHED;
      LDB(B1, 0, 1); STAGEB(SB(0, 0), bcol, t + 2);
      BAR; WAIT_L(0); MMA(0, 1, At, B1); BAR;
      LDA(At, 0, 1); STAGEA(SA(0, 0), brow, t + 2);
      BAR; WAIT_L(0); MMA(1, 0, At, B0); BAR; SCHED;
      STAGEB(SB(0, 1), bcol + HALF, t + 2);
      WAIT_V(6); BAR; MMA(1, 1, At, B1); BAR;
      LDB(B0, 1, 0); SCHED; LDA(At, 1, 0); STAGEA(SA(0, 1), brow + HALF, t + 2);
      WAIT_L(8); BAR; WAIT_L(0); MMA(0, 0, At, B0); BAR; SCHED;
      LDB(B1, 1, 1); STAGEB(SB(1, 0), bcol, t + 3);
      BAR; WAIT_L(0); MMA(0, 1, At, B1); BAR;
      LDA(At, 1, 1); STAGEA(SA(1, 0), brow, t + 3);
      BAR; WAIT_L(0); MMA(1, 0, At, B0); BAR; SCHED;
      STAGEB(SB(1, 1), bcol + HALF, t + 3);
      WAIT_V(6); BAR; MMA(1, 1, At, B1); BAR;
    }
    { LDB(B0, 0, 0); LDA(At, 0, 0); STAGEA(SA(1, 1), brow + HALF, nt - 1);
      BAR; WAIT_L(0); MMA(0, 0, At, B0); BAR;
      LDB(B1, 0, 1); BAR; WAIT_L(0); MMA(0, 1, At, B1); BAR;
      LDA(At, 0, 1); WAIT_V(4); BAR; WAIT_L(0); MMA(1, 0, At, B0); MMA(1, 1, At, B1); BAR; }
    { LDB(B0, 1, 0); LDA(At, 1, 0); WAIT_V(2); BAR; WAIT_L(0); MMA(0, 0, At, B0); BAR;
      LDB(B1, 1, 1); WAIT_V(0); BAR; WAIT_L(0); MMA(0, 1, At, B1); BAR;
      LDA(At, 1, 1); BAR; WAIT_L(0); MMA(1, 0, At, B0); MMA(1, 1, At, B1); BAR; }
    if (wr == 0) BAR;
    if (st2 > 0) PROLOGUE_STAGES(pm2 * BM, pn2 * BM);
    asm volatile("" ::: "memory");
    const int t2_ = ltid(wv); const int wid2 = t2_ >> 6, lane2 = t2_ & 63, wr2 = wid2 >> 2, wc2 = wid2 & 3, fr2 = lane2 & 15, fq2 = lane2 >> 4;
    const int tokbase_t = (EPI == EPI_FT || EPI == EPI_VT) ? bcol : brow;
    const int mrow_t = (tokbase_t < NX) ? (tokbase_t >> 11) : 32;
    if constexpr (SWAP) {
      float4 cs[2][2], ct[2][2];
#pragma unroll
      for (int bj = 0; bj < 2; ++bj) {
        const int c = bcol + bj * HALF + wc2 * 32 + fq2 * 8;
        cs[bj][0] = cs[bj][1] = ct[bj][0] = ct[bj][1] = make_float4(0.f, 0.f, 0.f, 0.f);
        if constexpr (EPI == EPI_FT || EPI == EPI_VT) {
          if (e.stats) { f32x4 ra = row_rinv4(e.stats, c), rb = row_rinv4(e.stats, c + 4); cs[bj][0] = make_float4(ra[0], ra[1], ra[2], ra[3]); cs[bj][1] = make_float4(rb[0], rb[1], rb[2], rb[3]); }
        } else if constexpr (EPI == EPI_STORE || EPI == EPI_SQRELU) {
          if (e.stats) { const float* sp = e.shw + (size_t)mrow_t * 4096 + c; cs[bj][0] = *(const float4*)sp; cs[bj][1] = *(const float4*)(sp + 4); }
        } else if constexpr (EPI == EPI_RESID) {
          const float* gp = e.gate + (size_t)mrow_t * 6144 + c; cs[bj][0] = *(const float4*)gp; cs[bj][1] = *(const float4*)(gp + 4);
          if (e.hout) {
            const float* np = e.ngain + c; const float* scp = e.nscale + (size_t)mrow_t * 6144 + c;
            float4 n0 = *(const float4*)np, n1 = *(const float4*)(np + 4), c0 = *(const float4*)scp, c1 = *(const float4*)(scp + 4);
            ct[bj][0] = make_float4(n0.x * (1.f + c0.x), n0.y * (1.f + c0.y), n0.z * (1.f + c0.z), n0.w * (1.f + c0.w));
            ct[bj][1] = make_float4(n1.x * (1.f + c1.x), n1.y * (1.f + c1.y), n1.z * (1.f + c1.z), n1.w * (1.f + c1.w));
          }
        } else if constexpr (EPI == EPI_GLU) {
          cs[bj][0] = *(const float4*)(e.bias + c); cs[bj][1] = *(const float4*)(e.bias + c + 4);
        }
      }
      float rowss[2][4];
#pragma unroll
      for (int ai = 0; ai < 2; ++ai)
#pragma unroll
        for (int m = 0; m < 4; ++m) {
          const int row = brow + ai * HALF + wr2 * 64 + m * 16 + fr2;
          float rinv = 1.f;
          if constexpr (EPI == EPI_STORE || EPI == EPI_SQRELU) { if (e.stats) rinv = row_rinv(e.stats, row); }
          if constexpr (EPI == EPI_FT || EPI == EPI_VT) { rinv = e.stats ? e.shw[(size_t)mrow_t * 4096 + row] : 0.f; }
          float ss = 0.f;
#pragma unroll
          for (int bj = 0; bj < 2; ++bj)
            ss += epi8<EPI>(e, row, bcol + bj * HALF + wc2 * 32 + fq2 * 8, acc[ai][bj][m][0], acc[ai][bj][m][1], rinv, cs[bj][0], cs[bj][1], ct[bj][0], ct[bj][1]);
          rowss[ai][m] = ss;
        }
      if constexpr (EPI == EPI_RESID) {
        if (e.hout) {
          float* red = (float*)SA(1, 1);
#pragma unroll
          for (int ai = 0; ai < 2; ++ai)
#pragma unroll
            for (int m = 0; m < 4; ++m) {
              float v = rowss[ai][m];
              v += shx(v, 16, lane2); v += shx(v, 32, lane2);
              if (fq2 == 0) red[(ai * HALF + wr2 * 64 + m * 16 + fr2) * 4 + wc2] = v;
            }
          WAIT_L(0); BAR;
          if (t2_ < 256) {
            float4 q = *(const float4*)(red + t2_ * 4);
            e.stats_out[(size_t)pn * NT + brow + t2_] = (q.x + q.y) + (q.z + q.w);
          }
        }
      }
    } else {
      float shv[2][2];
#pragma unroll
      for (int bj = 0; bj < 2; ++bj)
#pragma unroll
        for (int n = 0; n < 2; ++n) shv[bj][n] = e.stats ? e.shw[(size_t)mrow_t * 4096 + bcol + bj * HALF + wc2 * 32 + n * 16 + fr2] : 0.f;
#pragma unroll
      for (int ai = 0; ai < 2; ++ai)
#pragma unroll
        for (int m = 0; m < 4; ++m) {
          const int row4 = brow + ai * HALF + wr2 * 64 + m * 16 + fq2 * 4;
          f32x4 rinv4 = {1.f, 1.f, 1.f, 1.f};
          if (e.stats) rinv4 = row_rinv4(e.stats, row4);
#pragma unroll
          for (int bj = 0; bj < 2; ++bj)
#pragma unroll
            for (int n = 0; n < 2; ++n) epi4<EPI>(e, row4, bcol + bj * HALF + wc2 * 32 + n * 16 + fr2, acc[ai][bj][m][n], rinv4, shv[bj][n]);
        }
    }
    if (st2 < 0) break;
    pm = pm2; pn = pn2;
  }
  WAIT_V(0);
#undef PROLOGUE_STAGES
#undef SA
#undef SB
#undef STAGEA
#undef STAGEB
#undef LDA
#undef LDB
#undef MMA
}

DI void transpose_mat(const float* __restrict__ src, int ldn, int n0, int K, int N, u16* __restrict__ dst, float* lds, int wv) {
  const int tilesN = N / 64, ntile = (K / 64) * tilesN, tid = ltid(wv);
  for (int t = blockIdx.x; t < ntile; t += gridDim.x) {
    const int tk = t / tilesN, tn = t - tk * tilesN, k0 = tk * 64, nn0 = tn * 64;
    const int r = tid >> 4, c4 = (tid & 15) * 4;
#pragma unroll
    for (int i = 0; i < 2; ++i) {
      int rr = r + 32 * i;
      float4 v = *(const float4*)(src + (size_t)(k0 + rr) * ldn + n0 + nn0 + c4);
      lds[rr * 65 + c4 + 0] = v.x; lds[rr * 65 + c4 + 1] = v.y; lds[rr * 65 + c4 + 2] = v.z; lds[rr * 65 + c4 + 3] = v.w;
    }
    __syncthreads();
    const int n = tid >> 3, kc = (tid & 7) * 8;
    uint4 o;
    o.x = pack2(lds[(kc + 0) * 65 + n], lds[(kc + 1) * 65 + n]);
    o.y = pack2(lds[(kc + 2) * 65 + n], lds[(kc + 3) * 65 + n]);
    o.z = pack2(lds[(kc + 4) * 65 + n], lds[(kc + 5) * 65 + n]);
    o.w = pack2(lds[(kc + 6) * 65 + n], lds[(kc + 7) * 65 + n]);
    *(uint4*)(dst + (size_t)(nn0 + n) * K + k0 + kc) = o;
    __syncthreads();
  }
}

DI void phase_prep(const Params& p, unsigned char* shm, int wv) {
  float* lds = (float*)shm;
  unsigned char* ws = p.ws;
  const int tid = ltid(wv), lane = tid & 63, w = tid >> 6;
  for (int i = 0; i < 4; ++i) {
    transpose_mat(p.in[8] + (size_t)i * 1024 * 4096, 4096, 0, 1024, 4096, (u16*)(ws + OFF_W1T) + (size_t)i * 4096 * 1024, lds, wv);
    transpose_mat(p.in[9] + (size_t)i * 4096 * 1024, 1024, 0, 4096, 1024, (u16*)(ws + OFF_W2T) + (size_t)i * 4096 * 1024, lds, wv);
  }
  for (int j = 0; j < 2; ++j) {
    transpose_mat(p.in[10] + (size_t)j * 1024 * 1024, 1024, 512, 1024, 512, (u16*)(ws + OFF_EVIN) + (size_t)j * 1536 * 1024 + 1024 * 1024, lds, wv);
    transpose_mat(p.in[11] + (size_t)j * 1024 * 1024, 1024, 0, 1024, 1024, (u16*)(ws + OFF_EVOUT) + (size_t)j * 1024 * 1024, lds, wv);
    transpose_mat(p.in[20] + (size_t)j * 512 * 512, 512, 0, 512, 512, (u16*)(ws + OFF_GLU) + (size_t)j * 512 * 512, lds, wv);
    transpose_mat(p.in[22] + (size_t)j * 1024 * 3072, 3072, 0, 1024, 3072, (u16*)(ws + OFF_ODIN) + (size_t)j * 3072 * 1024, lds, wv);
    transpose_mat(p.in[23] + (size_t)j * 1024 * 1024, 1024, 0, 1024, 1024, (u16*)(ws + OFF_ODOUT) + (size_t)j * 1024 * 1024, lds, wv);
  }
  for (int t = blockIdx.x; t < 128; t += gridDim.x) {
    const int j = t >> 6, g = (t >> 4) & 3, k0 = (t & 15) * 64;
    float* wl = lds; float* tab = lds + 8192;
    __syncthreads();
#pragma unroll
    for (int i = 0; i < 16; ++i) {
      int idx = tid + 512 * i, kk = idx >> 7, c = idx & 127;
      wl[idx] = p.in[10][((size_t)j * 1024 + k0 + kk) * 1024 + g * 128 + c];
    }
    if (tid < 128) { tab[tid] = cospif(tid * (1.f / 64.f)); tab[128 + tid] = sinpif(tid * (1.f / 64.f)); }
    __syncthreads();
    const int pc = tid & 255, part = pc >> 7, cp = pc & 127, kh = tid >> 8;
    float acc[32];
#pragma unroll
    for (int kk = 0; kk < 32; ++kk) acc[kk] = 0.f;
    for (int c = 0; c < 128; ++c) {
      const float tv = tab[part * 128 + ((c * cp) & 127)];
#pragma unroll
      for (int kk = 0; kk < 32; ++kk) acc[kk] += wl[(kh * 32 + kk) * 128 + c] * tv;
    }
    const float sc = 0.08838834764831845f;
    u16* dst = (u16*)(ws + OFF_EVIN) + (size_t)j * 1536 * 1024 + (size_t)(part * 512 + g * 128 + cp) * 1024 + k0 + kh * 32;
#pragma unroll
    for (int q = 0; q < 4; ++q) {
      uint4 o;
      o.x = pack2(acc[q * 8 + 0] * sc, acc[q * 8 + 1] * sc); o.y = pack2(acc[q * 8 + 2] * sc, acc[q * 8 + 3] * sc);
      o.z = pack2(acc[q * 8 + 4] * sc, acc[q * 8 + 5] * sc); o.w = pack2(acc[q * 8 + 6] * sc, acc[q * 8 + 7] * sc);
      *(uint4*)(dst + q * 8) = o;
    }
  }
  {
    const int gt = blockIdx.x * 512 + tid, nth = gridDim.x * 512;
    u16* F = (u16*)(ws + OFF_F2048);
    const float s = 0.022097086912079608f;
    for (int idx = gt; idx < 2048 * 512; idx += nth) {
      const int lp = idx >> 9, k8 = (idx & 511) * 8;
      float v[8];
#pragma unroll
      for (int jj = 0; jj < 8; ++jj) {
        int k = k8 + jj;
        if (k < 2048) { int m = (k * lp) & 2047; v[jj] = cospif(m * (1.f / 1024.f)) * s; }
        else { int m = ((k - 2048) * lp) & 2047; v[jj] = -sinpif(m * (1.f / 1024.f)) * s; }
      }
      uint4 o; o.x = pack2(v[0], v[1]); o.y = pack2(v[2], v[3]); o.z = pack2(v[4], v[5]); o.w = pack2(v[6], v[7]);
      *(uint4*)(F + (size_t)lp * 4096 + k8) = o;
    }
    u16* F2 = (u16*)(ws + OFF_F256);
    for (int idx = gt; idx < 256 * 64; idx += nth) {
      const int lp = idx >> 6, k8 = (idx & 63) * 8;
      float v[8];
#pragma unroll
      for (int jj = 0; jj < 8; ++jj) {
        int k = k8 + jj;
        if (k < 256) { int m = (k * lp) & 255; v[jj] = cospif(m * (1.f / 128.f)) * 0.0625f; }
        else { int m = ((k - 256) * lp) & 255; v[jj] = -sinpif(m * (1.f / 128.f)) * 0.0625f; }
      }
      uint4 o; o.x = pack2(v[0], v[1]); o.y = pack2(v[2], v[3]); o.z = pack2(v[4], v[5]); o.w = pack2(v[6], v[7]);
      *(uint4*)(F2 + (size_t)lp * 512 + k8) = o;
    }
  }
  {
    float* modv = (float*)(ws + OFF_MODV);
    float* sl = lds + w * (33 * 64);
    float* red = lds;
    for (int t = blockIdx.x; t < 384; t += gridDim.x) {
      const int i = t / 96, n0 = (t % 96) * 64, n = n0 + lane;
      float acc[33];
#pragma unroll
      for (int r = 0; r < 33; ++r) acc[r] = 0.f;
      const float* wbase = p.in[6] + (size_t)i * 1024 * 6144 + n;
      __syncthreads();
      for (int half = 0; half < 2; ++half) {
        const int kbase = w * 128 + half * 64;
        __builtin_amdgcn_wave_barrier();
#pragma unroll
        for (int r = 0; r < 33; ++r) {
          const float cv = (r < 32) ? p.in[1][r * 1024 + kbase + lane] : p.in[3][kbase + lane];
          sl[r * 64 + lane] = cv / (1.f + __expf(-cv));
        }
        __builtin_amdgcn_wave_barrier();
        for (int k = 0; k < 64; k += 16) {
          float wv16[16];
#pragma unroll
          for (int u = 0; u < 16; ++u) wv16[u] = wbase[(size_t)(kbase + k + u) * 6144];
#pragma unroll
          for (int r = 0; r < 33; ++r) {
            const float* sp = sl + r * 64 + k;
            float4 s0 = *(const float4*)sp, s1 = *(const float4*)(sp + 4), s2 = *(const float4*)(sp + 8), s3 = *(const float4*)(sp + 12);
            acc[r] += s0.x * wv16[0] + s0.y * wv16[1] + s0.z * wv16[2] + s0.w * wv16[3] + s1.x * wv16[4] + s1.y * wv16[5] + s1.z * wv16[6] + s1.w * wv16[7]
                    + s2.x * wv16[8] + s2.y * wv16[9] + s2.z * wv16[10] + s2.w * wv16[11] + s3.x * wv16[12] + s3.y * wv16[13] + s3.z * wv16[14] + s3.w * wv16[15];
          }
        }
      }
      __syncthreads();
#pragma unroll
      for (int r = 0; r < 33; ++r) red[(w * 33 + r) * 64 + lane] = acc[r];
      __syncthreads();
      for (int o = tid; o < 33 * 64; o += 512) {
        const int r = o >> 6, c = o & 63;
        float sum = 0.f;
#pragma unroll
        for (int ww = 0; ww < 8; ++ww) sum += red[(ww * 33 + r) * 64 + c];
        modv[((size_t)i * 33 + r) * 6144 + n0 + c] = sum + p.in[7][i * 6144 + n0 + c];
      }
    }
  }
}

DI void phase_sh(const Params& p, int wv) {
  const float* modv = (const float*)(p.ws + OFF_MODV);
  u16* SH = (u16*)(p.ws + OFF_SH);
  const int gt = blockIdx.x * 512 + ltid(wv), nth = gridDim.x * 512;
  for (int idx = gt; idx < 8 * 33 * 128; idx += nth) {
    const int q = idx / (33 * 128), rem = idx - q * (33 * 128), r = rem >> 7, k8 = (rem & 127) * 8;
    const int i = q >> 1, chunk = (q & 1) ? 3 : 0;
    const float* src = modv + ((size_t)i * 33 + r) * 6144 + chunk * 1024 + k8;
    float4 a = *(const float4*)src, b = *(const float4*)(src + 4);
    uint4 o; o.x = pack2(a.x, a.y); o.y = pack2(a.z, a.w); o.z = pack2(b.x, b.y); o.w = pack2(b.z, b.w);
    *(uint4*)(SH + ((size_t)q * 256 + r) * 1024 + k8) = o;
  }
}

DI void phase_norm(const Params& p, int layer, int which, const float* xsrc, const float* csrc, int nrows, int wv) {
  const int tid = ltid(wv); const int lane = tid & 63, w = tid >> 6;
  const float* g = p.in[which == 1 ? 4 : 5] + layer * 1024;
  const float* modv = (const float*)(p.ws + OFF_MODV) + (size_t)layer * 33 * 6144;
  u16* H = (u16*)(p.ws + OFF_H);
  const int shc = (which == 1 ? 0 : 3) * 1024, scc = (which == 1 ? 1 : 4) * 1024;
  const int rstride = gridDim.x * 8;
  int row = blockIdx.x * 8 + w;
  float4 nv[4];
  if (row < nrows) {
    const float* src = (row < NX) ? xsrc + (size_t)row * 1024 : csrc + (size_t)(row - NX) * 1024;
#pragma unroll
    for (int i = 0; i < 4; ++i) nv[i] = *(const float4*)(src + (lane + 64 * i) * 4);
  }
  for (; row < nrows; row += rstride) {
    const int mrow = (row < NX) ? (row >> 11) : 32;
    const float* mv = modv + (size_t)mrow * 6144;
    float4 v[4]; float ss = 0.f;
#pragma unroll
    for (int i = 0; i < 4; ++i) { v[i] = nv[i]; ss += v[i].x * v[i].x + v[i].y * v[i].y + v[i].z * v[i].z + v[i].w * v[i].w; }
    const int nrow = row + rstride;
    if (nrow < nrows) {
      const float* src = (nrow < NX) ? xsrc + (size_t)nrow * 1024 : csrc + (size_t)(nrow - NX) * 1024;
#pragma unroll
      for (int i = 0; i < 4; ++i) nv[i] = *(const float4*)(src + (lane + 64 * i) * 4);
    }
    ss = wave_sum(ss, lane);
    const float rinv = rsqrtf(ss * (1.f / 1024.f) + 1e-6f);
#pragma unroll
    for (int i = 0; i < 4; ++i) {
      const int col = (lane + 64 * i) * 4;
      float4 gg = *(const float4*)(g + col), sc = *(const float4*)(mv + scc + col), sh = *(const float4*)(mv + shc + col);
      float y0 = v[i].x * rinv * gg.x * (1.f + sc.x) + sh.x, y1 = v[i].y * rinv * gg.y * (1.f + sc.y) + sh.y;
      float y2 = v[i].z * rinv * gg.z * (1.f + sc.z) + sh.z, y3 = v[i].w * rinv * gg.w * (1.f + sc.w) + sh.w;
      uint2 o; o.x = pack2(y0, y1); o.y = pack2(y2, y3);
      *(uint2*)(H + (size_t)row * 1024 + col) = o;
    }
  }
}

DI void phase_qknorm(const Params& p, int j, int wv) {
  const int tid = ltid(wv); const int lane = tid & 63, w = tid >> 6;
  const int tsel = lane >> 5, hh = (lane >> 1) & 15, axis = lane & 1;
  const int qk = 1;
  u16* QKB = (u16*)(p.ws + R_QKB);
  const float* gam = p.in[qk ? 25 : 24] + j * 64 + axis * 32;
  float gm[32];
#pragma unroll
  for (int d = 0; d < 32; ++d) gm[d] = gam[d];
  const float qscale = qk ? 1.f : 0.125f * 1.4426950408889634f;
  const int rstride = gridDim.x * 16;
  const int lcol = qk * 1024 + hh * 64 + axis * 32;
  uint4 nu[4];
  {
    const int row0 = (blockIdx.x * 8 + w) * 2 + tsel;
    if (row0 < NT) {
#pragma unroll
      for (int q = 0; q < 4; ++q) nu[q] = *(const uint4*)(QKB + (size_t)row0 * 2048 + lcol + q * 8);
    }
  }
  for (int row = (blockIdx.x * 8 + w) * 2 + tsel; row < NT; row += rstride) {
    u16* ptr = QKB + (size_t)row * 2048 + lcol;
    float v[32]; float ss = 0.f;
    uint4 cu[4];
#pragma unroll
    for (int q = 0; q < 4; ++q) cu[q] = nu[q];
    if (row + rstride < NT) {
#pragma unroll
      for (int q = 0; q < 4; ++q) nu[q] = *(const uint4*)(QKB + (size_t)(row + rstride) * 2048 + lcol + q * 8);
    }
#pragma unroll
    for (int q = 0; q < 4; ++q) {
      uint4 u = cu[q];
      v[q * 8 + 0] = bflo(u.x); v[q * 8 + 1] = bfhi(u.x); v[q * 8 + 2] = bflo(u.y); v[q * 8 + 3] = bfhi(u.y);
      v[q * 8 + 4] = bflo(u.z); v[q * 8 + 5] = bfhi(u.z); v[q * 8 + 6] = bflo(u.w); v[q * 8 + 7] = bfhi(u.w);
    }
#pragma unroll
    for (int d = 0; d < 32; ++d) ss += v[d] * v[d];
    ss += shx(ss, 1, lane);
    const float rinv = rsqrtf(ss * (1.f / 64.f) + 1e-6f);
#pragma unroll
    for (int d = 0; d < 32; ++d) v[d] = v[d] * rinv * gm[d];
    if (row < NX) {
      const int l = row & 2047;
      const float pos = (float)(axis ? (l & 63) : (l >> 6));
#pragma unroll
      for (int i2 = 0; i2 < 16; ++i2) {
        const float invf = exp2f(-(float)i2 * 0.8304820237218406f);
        const float ang = pos * invf;
        float sn, cs; __sincosf(ang, &sn, &cs);
        const float x1 = v[i2], x2 = v[16 + i2];
        v[i2] = x1 * cs - x2 * sn; v[16 + i2] = x1 * sn + x2 * cs;
      }
    }
#pragma unroll
    for (int q = 0; q < 4; ++q) {
      uint4 o;
      o.x = pack2(v[q * 8 + 0] * qscale, v[q * 8 + 1] * qscale); o.y = pack2(v[q * 8 + 2] * qscale, v[q * 8 + 3] * qscale);
      o.z = pack2(v[q * 8 + 4] * qscale, v[q * 8 + 5] * qscale); o.w = pack2(v[q * 8 + 6] * qscale, v[q * 8 + 7] * qscale);
      *(uint4*)(ptr + q * 8) = o;
    }
  }
}

#define MFMA32(a, b, c) __builtin_amdgcn_mfma_f32_32x32x16_bf16((a), (b), (c), 0, 0, 0)
DI void phase_attn(const Params& p, int j, float lam_init, bool last, unsigned char* shm, int wv, int slot) {
  const u16* QKB = (const u16*)(p.ws + R_QKB);
  const u16* VT = (const u16*)(p.ws + R_VT);
  u16* OB = (u16*)(p.ws + R_MIX);
  const int tid = ltid(wv), lane = tid & 63, w = tid >> 6;
  const int r = lane & 31, hh = lane >> 5, qsub = w >> 1, map = w & 1;
  float lam;
  {
    const float* lp = p.in[26] + j * 256;
    float a = lp[lane] * lp[64 + lane], b = lp[128 + lane] * lp[192 + lane];
    a = wave_sum(a, lane); b = wave_sum(b, lane);
    lam = __expf(a) - __expf(b) + lam_init;
  }
  bool fastsm;
  {
    float gq = fabsf(p.in[24][j * 64 + lane]), gk = fabsf(p.in[25][j * 64 + lane]);
#pragma unroll
    for (int o = 32; o >= 1; o >>= 1) { gq = fmaxf(gq, shx(gq, o, lane)); gk = fmaxf(gk, shx(gk, o, lane)); }
    const float bound = 11.6f * gq * gk;
    fastsm = __builtin_amdgcn_readfirstlane((int)(bound <= 100.f)) != 0;
  }
  const float* ghead = p.in[27] + j * 128;
  const int ntask = 4096 + (last ? 0 : 512);
  const int nb = gridDim.x;
  const int krow = tid >> 3, kch = tid & 7;
  if (wv >= 4) __builtin_amdgcn_s_setprio(1);
  for (int task = slot; task < ntask; task += nb) {
    int b, head, qrow0, kt0, nkt;
    if (task < 4096) { b = task >> 7; head = (task >> 4) & 7; qrow0 = b * 2048 + (task & 15) * 128; kt0 = 0; nkt = 36; }
    else { int t2 = task - 4096; b = t2 >> 4; head = (t2 >> 1) & 7; qrow0 = NX + b * 256 + (t2 & 1) * 128; kt0 = 32; nkt = 4; }
    const u16* vbase = VT + ((size_t)(b * 8 + head) * 128) * 2304;
    f32x16 O[4];
#pragma unroll
    for (int d = 0; d < 4; ++d)
#pragma unroll
      for (int i = 0; i < 16; ++i) O[d][i] = 0.f;
    float m_run = 0.f, l_run = 0.f;
    const int drow = w * 8 + (lane >> 3); const int dcg = (lane & 7) ^ ((drow >> 1) & 7);
    const u16* kptr = QKB + (size_t)((kt0 < 32) ? (b * 2048 + kt0 * 64 + drow) : (NX + b * 256 + (kt0 - 32) * 64 + drow)) * 2048 + 1024 + head * 128 + dcg * 8;
    const u16* vptr = vbase + (size_t)drow * 2304 + kt0 * 64 + dcg * 8;
    const u16* vptr2 = vptr + (size_t)64 * 2304;
    const unsigned ldsoff = w * 1024 + lane * 16;
    int dma_kt = kt0;
#define DMA_TILE(kt_, ks_, vs_) do { \
      unsigned char* kdst = shm + (ks_) * 16384 + ldsoff; \
      unsigned char* vdst = shm + 49152 + (vs_) * 16384 + ldsoff; \
      __builtin_amdgcn_global_load_lds((const unsigned*)kptr, (unsigned*)kdst, 16, 0, 0); \
      __builtin_amdgcn_global_load_lds((const unsigned*)(kptr + 64), (unsigned*)(kdst + 8192), 16, 0, 0); \
      __builtin_amdgcn_global_load_lds((const unsigned*)vptr, (unsigned*)vdst, 16, 0, 0); \
      __builtin_amdgcn_global_load_lds((const unsigned*)vptr2, (unsigned*)(vdst + 8192), 16, 0, 0); \
      ++dma_kt; vptr += 64; vptr2 += 64; \
      if (dma_kt == 32) kptr = QKB + (size_t)(NX + b * 256 + drow) * 2048 + 1024 + head * 128 + dcg * 8;     \
      else kptr += (size_t)64 * 2048; } while (0)
    const int swz = ((r >> 1) & 7);
#define QK_SOFTMAX(ks_, FAST_) do { \
      const unsigned char* kb_ = shm + (ks_) * 16384 + map * 8192; \
      f32x16 S[2]; \
      bf16x8 kf[2][4]; \
      _Pragma("unroll") for (int kb = 0; kb < 2; ++kb) _Pragma("unroll") for (int kk = 0; kk < 4; ++kk) \
        kf[kb][kk] = *(const bf16x8*)(kb_ + (kb * 32 + r) * 128 + (((kk * 2 + hh) ^ swz) << 4)); \
      _Pragma("unroll") for (int kb = 0; kb < 2; ++kb) _Pragma("unroll") for (int i = 0; i < 16; ++i) S[kb][i] = (FAST_) ? 0.f : -m_run; \
      __builtin_amdgcn_sched_barrier(0); \
      _Pragma("unroll") for (int kk = 0; kk < 4; ++kk) _Pragma("unroll") for (int kb = 0; kb < 2; ++kb) \
        S[kb] = MFMA32(kf[kb][kk], qf[kk], S[kb]); \
      __builtin_amdgcn_sched_barrier(0); \
      if (!(FAST_)) {   \
      float mx = S[0][0]; \
      _Pragma("unroll") for (int i = 1; i < 16; ++i) mx = fmaxf(mx, S[0][i]); \
      _Pragma("unroll") for (int i = 0; i < 16; ++i) mx = fmaxf(mx, S[1][i]); \
      mx = fmaxf(mx, shx(mx, 32, lane)); \
      const bool need = (it == 0) || (mx > 8.f); \
      if (__builtin_amdgcn_ballot_w64(need) != 0ull) { \
        const float delta = need ? mx : 0.f; \
        const float alpha = __builtin_amdgcn_exp2f(-delta); \
        m_run += delta; l_run *= alpha; \
        _Pragma("unroll") for (int d = 0; d < 4; ++d) _Pragma("unroll") for (int i = 0; i < 16; ++i) O[d][i] *= alpha; \
        _Pragma("unroll") for (int kb = 0; kb < 2; ++kb) _Pragma("unroll") for (int i = 0; i < 16; ++i) S[kb][i] -= delta; } } \
      float ps = 0.f; \
      _Pragma("unroll") for (int kb = 0; kb < 2; ++kb) _Pragma("unroll") for (int i = 0; i < 16; ++i) { float e_ = __builtin_amdgcn_exp2f(S[kb][i]); S[kb][i] = e_; ps += e_; } \
      l_run += ps; \
      _Pragma("unroll") for (int kb = 0; kb < 2; ++kb) _Pragma("unroll") for (int s2 = 0; s2 < 2; ++s2) _Pragma("unroll") for (int q4 = 0; q4 < 4; ++q4) \
        Pk[(kb * 2 + s2) * 4 + q4] = pack2(S[kb][8 * s2 + 2 * q4], S[kb][8 * s2 + 2 * q4 + 1]); } while (0)
#define PV(vs_) do { \
      const unsigned char* vb_ = shm + 49152 + (vs_) * 16384; \
      bf16x8 vf[4][4]; \
      _Pragma("unroll") for (int ks4 = 0; ks4 < 4; ++ks4) _Pragma("unroll") for (int d = 0; d < 4; ++d) \
        vf[ks4][d] = *(const bf16x8*)(vb_ + (d * 32 + r) * 128 + (((ks4 * 2 + hh) ^ swz) << 4)); \
      __builtin_amdgcn_sched_barrier(0); \
      _Pragma("unroll") for (int ks4 = 0; ks4 < 4; ++ks4) { \
        uint4 pu = make_uint4(Pk[ks4 * 4 + 0], Pk[ks4 * 4 + 1], Pk[ks4 * 4 + 2], Pk[ks4 * 4 + 3]); \
        bf16x8 pf = __builtin_bit_cast(bf16x8, pu); \
        _Pragma("unroll") for (int d = 0; d < 4; ++d) O[d] = MFMA32(vf[ks4][d], pf, O[d]); } \
      __builtin_amdgcn_sched_barrier(0); } while (0)
    unsigned Pk[16];
#pragma unroll
    for (int i = 0; i < 16; ++i) Pk[i] = 0u;
    DMA_TILE(kt0, 0, 0);
    if (1 < nkt) DMA_TILE(kt0 + 1, 1, 1);
    bf16x8 qf[4];
    {
      const int qtok = qrow0 + qsub * 32 + r;
      const u16* qp = QKB + (size_t)qtok * 2048 + head * 128 + map * 64 + hh * 8;
      float v[4][8]; float ss = 0.f;
#pragma unroll
      for (int kk = 0; kk < 4; ++kk) {
        uint4 u = *(const uint4*)(qp + kk * 16);
        v[kk][0] = bflo(u.x); v[kk][1] = bfhi(u.x); v[kk][2] = bflo(u.y); v[kk][3] = bfhi(u.y);
        v[kk][4] = bflo(u.z); v[kk][5] = bfhi(u.z); v[kk][6] = bflo(u.w); v[kk][7] = bfhi(u.w);
      }
#pragma unroll
      for (int kk = 0; kk < 4; ++kk)
#pragma unroll
        for (int jq = 0; jq < 8; ++jq) ss += v[kk][jq] * v[kk][jq];
      ss += shx(ss, 32, lane);
      const float rinv = rsqrtf(ss * (1.f / 64.f) + 1e-6f);
      const float* gq = p.in[24] + j * 64 + hh * 8;
#pragma unroll
      for (int kk = 0; kk < 4; ++kk) {
        float4 g0 = *(const float4*)(gq + kk * 16), g1 = *(const float4*)(gq + kk * 16 + 4);
        v[kk][0] *= rinv * g0.x; v[kk][1] *= rinv * g0.y; v[kk][2] *= rinv * g0.z; v[kk][3] *= rinv * g0.w;
        v[kk][4] *= rinv * g1.x; v[kk][5] *= rinv * g1.y; v[kk][6] *= rinv * g1.z; v[kk][7] *= rinv * g1.w;
      }
      if (task < 4096) {
        const int l = qtok & 2047;
        const float prow = (float)(l >> 6), pcol = (float)(l & 63);
#pragma unroll
        for (int jq = 0; jq < 8; ++jq) {
          const float invf = exp2f(-(float)(hh * 8 + jq) * 0.8304820237218406f);
          float sn, cs;
          __sincosf(prow * invf, &sn, &cs);
          { const float x1 = v[0][jq], x2 = v[1][jq]; v[0][jq] = x1 * cs - x2 * sn; v[1][jq] = x1 * sn + x2 * cs; }
          __sincosf(pcol * invf, &sn, &cs);
          { const float x1 = v[2][jq], x2 = v[3][jq]; v[2][jq] = x1 * cs - x2 * sn; v[3][jq] = x1 * sn + x2 * cs; }
        }
      }
      const float qs = 0.125f * 1.4426950408889634f;
#pragma unroll
      for (int kk = 0; kk < 4; ++kk) {
        uint4 o = make_uint4(pack2(v[kk][0] * qs, v[kk][1] * qs), pack2(v[kk][2] * qs, v[kk][3] * qs), pack2(v[kk][4] * qs, v[kk][5] * qs), pack2(v[kk][6] * qs, v[kk][7] * qs));
        qf[kk] = __builtin_bit_cast(bf16x8, o);
      }
    }
    if (1 < nkt) asm volatile("s_waitcnt vmcnt(4)" ::: "memory");
    else asm volatile("s_waitcnt vmcnt(0)" ::: "memory");
    __builtin_amdgcn_s_barrier();
    int ks = 0, vs = 0;
#define ATT_COMPUTE(FAST_) do { \
      if (map == 0) { QK_SOFTMAX(ks, FAST_); PV(vs); } \
      else { const int vsp = (vs + 3) & 3; if (it > 0) PV(vsp); QK_SOFTMAX(ks, FAST_); } } while (0)
#define ATT_LOOP(FAST_) \
    for (int it = 0; it < nkt; ++it) { \
      const int ks2 = (ks == 0) ? 2 : ks - 1; \
      if (it + 2 < nkt) DMA_TILE(kt0 + it + 2, ks2, (vs + 2) & 3); \
      ATT_COMPUTE(FAST_); \
      if (it + 2 < nkt) asm volatile("s_waitcnt vmcnt(4)" ::: "memory"); \
      else asm volatile("s_waitcnt vmcnt(0)" ::: "memory"); \
      __builtin_amdgcn_s_barrier(); \
      ks = (ks == 2) ? 0 : ks + 1; \
      vs = (vs + 1) & 3; \
    }
    if (fastsm) { ATT_LOOP(true) } else { ATT_LOOP(false) }
#undef ATT_LOOP
#undef ATT_COMPUTE
    if (map == 1) { const int vsp = (vs + 3) & 3; PV(vsp); }
    __syncthreads();
#undef DMA_TILE
#undef QK_SOFTMAX
#undef PV
    const float ltot = l_run + shx(l_run, 32, lane);
    const float inv = 1.f / ltot;
    float* X = (float*)shm;
    const int q = qsub * 32 + r;
    if (map == 1) {
#pragma unroll
      for (int d = 0; d < 4; ++d)
#pragma unroll
        for (int g4 = 0; g4 < 4; ++g4) {
          float4 o; o.x = O[d][g4 * 4 + 0] * inv; o.y = O[d][g4 * 4 + 1] * inv; o.z = O[d][g4 * 4 + 2] * inv; o.w = O[d][g4 * 4 + 3] * inv;
          *(float4*)(X + q * 132 + d * 32 + g4 * 8 + hh * 4) = o;
        }
    }
    __syncthreads();
    if (map == 0) {
      float ss = 0.f;
#pragma unroll
      for (int d = 0; d < 4; ++d)
#pragma unroll
        for (int g4 = 0; g4 < 4; ++g4) {
          float4 x2 = *(const float4*)(X + q * 132 + d * 32 + g4 * 8 + hh * 4);
          float o0 = O[d][g4 * 4 + 0] * inv - lam * x2.x, o1 = O[d][g4 * 4 + 1] * inv - lam * x2.y;
          float o2 = O[d][g4 * 4 + 2] * inv - lam * x2.z, o3 = O[d][g4 * 4 + 3] * inv - lam * x2.w;
          O[d][g4 * 4 + 0] = o0; O[d][g4 * 4 + 1] = o1; O[d][g4 * 4 + 2] = o2; O[d][g4 * 4 + 3] = o3;
          ss += o0 * o0 + o1 * o1 + o2 * o2 + o3 * o3;
        }
      ss += shx(ss, 32, lane);
      const float rinv = rsqrtf(ss * (1.f / 128.f) + 1e-6f) * (1.f - lam_init);
      unsigned char* os = shm + 67584 + q * 272;
#pragma unroll
      for (int d = 0; d < 4; ++d)
#pragma unroll
        for (int g4 = 0; g4 < 4; ++g4) {
          const int dv = d * 32 + g4 * 8 + hh * 4;
          float4 gh = *(const float4*)(ghead + dv);
          uint2 o; o.x = pack2(O[d][g4 * 4 + 0] * rinv * gh.x, O[d][g4 * 4 + 1] * rinv * gh.y);
          o.y = pack2(O[d][g4 * 4 + 2] * rinv * gh.z, O[d][g4 * 4 + 3] * rinv * gh.w);
          *(uint2*)(os + dv * 2) = o;
        }
    }
    asm volatile("s_waitcnt lgkmcnt(0)" ::: "memory");
    __builtin_amdgcn_s_barrier();
    {
      u16* ob = OB + (size_t)qrow0 * 1024 + head * 128;
#pragma unroll
      for (int i = 0; i < 4; ++i) {
        const int c = tid + 512 * i, row = c >> 4, c16 = c & 15;
        const uint4 v = *(const uint4*)(shm + 67584 + row * 272 + c16 * 16);
        *(uint4*)(ob + (size_t)row * 1024 + c16 * 8) = v;
      }
    }
    asm volatile("s_waitcnt lgkmcnt(0)" ::: "memory");
    __builtin_amdgcn_s_barrier();
  }
  __builtin_amdgcn_s_setprio(0);
}

DI float gelu_tanh(float y) {
  const float z = 0.7978845608028654f * (y + 0.044715f * y * y * y);
  const float t = 1.f - 2.f / (__expf(2.f * z) + 1.f);
  return 0.5f * y * (1.f + t);
}
DI int ssm_tok(int d, int b, int tau) {
  if (d == 0) return tau < 256 ? (NX + b * 256 + tau) : (b * 2048 + tau - 256);
  return tau < 256 ? (NX + b * 256 + 255 - tau) : (b * 2048 + 2047 - (tau - 256));
}
DI void phase_scan(const Params& p, int j, unsigned char* shm, int wv) {
  const int tid = ltid(wv), lane = tid & 63, w = tid >> 6;
  unsigned char* wl = shm + w * 12800;
  float* bu = (float*)wl;
  u16* Hl = (u16*)(wl + 8448);
  u16* BbT = (u16*)wl;
  const u16* ZS = (const u16*)(p.ws + R_ZS);
  const int col = lane & 15, quad = lane >> 4;
  for (int wg = blockIdx.x; wg < 256; wg += gridDim.x) {
    const int wt = wg * 8 + w;
    const int d = wt & 1, g = (wt >> 1) & 31, b = wt >> 6;
    const int dg = (j * 2 + d) * 32 + g;
    const int pst = lane;
    float abr, abi;
    {
      const float are = p.in[12][dg * 64 + pst], aim = p.in[13][dg * 64 + pst];
      const float dt = expf(p.in[14][dg]);
      const float er = expf(are * dt), ang = aim * dt;
      abr = er * cosf(ang); abi = er * sinf(ang);
      const float nr = abr - 1.f, ni = abi, den = are * are + aim * aim;
      const float cr = (nr * are + ni * aim) / den, ci = (ni * are - nr * aim) / den;
      const float* bre = p.in[15] + ((size_t)dg * 64 + pst) * 16;
      const float* bim = p.in[16] + ((size_t)dg * 64 + pst) * 16;
      __builtin_amdgcn_wave_barrier();
#pragma unroll
      for (int h = 0; h < 16; h += 2) {
        float br0 = bre[h], bi0 = bim[h], br1 = bre[h + 1], bi1 = bim[h + 1];
        *(unsigned*)(BbT + (2 * pst) * 16 + h) = pack2(cr * br0 - ci * bi0, cr * br1 - ci * bi1);
        *(unsigned*)(BbT + (2 * pst + 1) * 16 + h) = pack2(cr * bi0 + ci * br0, cr * bi1 + ci * br1);
      }
      __builtin_amdgcn_wave_barrier();
    }
    s16x4 bop[8];
#pragma unroll
    for (int nb = 0; nb < 8; ++nb) bop[nb] = *(const s16x4*)(BbT + (nb * 16 + col) * 16 + quad * 4);
    bf16x8 cop[4];
    {
      const float* cre = p.in[17] + ((size_t)dg * 16 + col) * 64;
      const float* cim = p.in[18] + ((size_t)dg * 16 + col) * 64;
#pragma unroll
      for (int kb = 0; kb < 4; ++kb) {
        float4 a = *(const float4*)(cre + kb * 16 + quad * 4), c = *(const float4*)(cim + kb * 16 + quad * 4);
        uint4 u = make_uint4(pack2(a.x, -c.x), pack2(a.y, -c.y), pack2(a.z, -c.z), pack2(a.w, -c.w));
        cop[kb] = __builtin_bit_cast(bf16x8, u);
      }
    }
    __builtin_amdgcn_wave_barrier();
    u16* Rd = (u16*)(p.ws + (d ? R_R1 : R_R0));
    float hr = 0.f, hi = 0.f;
    s16x4 ua = *(const s16x4*)(ZS + (size_t)ssm_tok(d, b, col) * 512 + g * 16 + quad * 4);
    s16x4 ub = *(const s16x4*)(ZS + (size_t)ssm_tok(d, b, 16 + col) * 512 + g * 16 + quad * 4);
    for (int c = 0; c < 144; ++c) {
      const int tau0 = c * 16;
      s16x4 ucur = ua;
      ua = ub;
      if (c + 2 < 144) ub = *(const s16x4*)(ZS + (size_t)ssm_tok(d, b, tau0 + 32 + col) * 512 + g * 16 + quad * 4);
#pragma unroll
      for (int nb = 0; nb < 8; ++nb) {
        f32x4 z = {0.f, 0.f, 0.f, 0.f};
        f32x4 r4 = __builtin_amdgcn_mfma_f32_16x16x16bf16_1k(ucur, bop[nb], z, 0, 0, 0);
#pragma unroll
        for (int jj = 0; jj < 4; ++jj) bu[(quad * 4 + jj) * 132 + nb * 16 + col] = r4[jj];
      }
      __builtin_amdgcn_wave_barrier();
      float2 bv[16];
#pragma unroll
      for (int t = 0; t < 16; ++t) bv[t] = *(const float2*)(bu + t * 132 + 2 * pst);
#pragma unroll
      for (int t = 0; t < 16; ++t) {
        const float nr = abr * hr - abi * hi + bv[t].x;
        const float ni = abr * hi + abi * hr + bv[t].y;
        hr = nr; hi = ni;
        *(unsigned*)(Hl + t * 136 + 2 * pst) = pack2(hr, hi);
      }
      __builtin_amdgcn_wave_barrier();
      f32x4 y = {0.f, 0.f, 0.f, 0.f};
#pragma unroll
      for (int kb = 0; kb < 4; ++kb) {
        bf16x8 af = *(const bf16x8*)(Hl + col * 136 + kb * 32 + quad * 8);
        y = __builtin_amdgcn_mfma_f32_16x16x32_bf16(cop[kb], af, y, 0, 0, 0);
      }
      {
        const int tok = ssm_tok(d, b, tau0 + col);
        uint2 o; o.x = pack2(y[0], y[1]); o.y = pack2(y[2], y[3]);
        *(uint2*)(Rd + (size_t)tok * 512 + g * 16 + quad * 4) = o;
      }
      __builtin_amdgcn_wave_barrier();
    }
    __syncthreads();
    __builtin_amdgcn_fence(__ATOMIC_ACQUIRE, "agent");
    {
      const u16* R0 = (const u16*)(p.ws + R_R0);
      const u16* R1 = (const u16*)(p.ws + R_R1);
      u16* YS = (u16*)(p.ws + R_YS);
      const int bb = wg >> 3, c0 = (wg & 7) * 64;
      const int c8 = c0 + (tid & 7) * 8;
      const float* dsk = p.in[19] + j * 512 + c8;
      const float4 d0 = *(const float4*)dsk, d1 = *(const float4*)(dsk + 4);
      for (int t0 = tid >> 3; t0 < 2304; t0 += 256) {
        uint4 u[4], a[4], bq[4]; size_t off[4];
#pragma unroll
        for (int q = 0; q < 4; ++q) {
          const int t = t0 + 64 * q;
          const int tok = (t < 2048) ? (bb * 2048 + t) : (NX + bb * 256 + (t - 2048));
          off[q] = (size_t)tok * 512 + c8;
          u[q] = *(const uint4*)(ZS + off[q]); a[q] = *(const uint4*)(R0 + off[q]); bq[q] = *(const uint4*)(R1 + off[q]);
        }
#pragma unroll
        for (int q = 0; q < 4; ++q) {
          float y0 = gelu_tanh(bflo(u[q].x) * d0.x + bflo(a[q].x) + bflo(bq[q].x)), y1 = gelu_tanh(bfhi(u[q].x) * d0.y + bfhi(a[q].x) + bfhi(bq[q].x));
          float y2 = gelu_tanh(bflo(u[q].y) * d0.z + bflo(a[q].y) + bflo(bq[q].y)), y3 = gelu_tanh(bfhi(u[q].y) * d0.w + bfhi(a[q].y) + bfhi(bq[q].y));
          float y4 = gelu_tanh(bflo(u[q].z) * d1.x + bflo(a[q].z) + bflo(bq[q].z)), y5 = gelu_tanh(bfhi(u[q].z) * d1.y + bfhi(a[q].z) + bfhi(bq[q].z));
          float y6 = gelu_tanh(bflo(u[q].w) * d1.z + bflo(a[q].w) + bflo(bq[q].w)), y7 = gelu_tanh(bfhi(u[q].w) * d1.w + bfhi(a[q].w) + bfhi(bq[q].w));
          uint4 o; o.x = pack2(y0, y1); o.y = pack2(y2, y3); o.z = pack2(y4, y5); o.w = pack2(y6, y7);
          *(uint4*)(YS + off[q]) = o;
        }
      }
    }
    __syncthreads();
  }
}

DI void phase_combine(const Params& p, int j, int wv) {
  const u16* ZS = (const u16*)(p.ws + R_ZS);
  const u16* R0 = (const u16*)(p.ws + R_R0);
  const u16* R1 = (const u16*)(p.ws + R_R1);
  u16* YS = (u16*)(p.ws + R_YS);
  const float* dsk = p.in[19] + j * 512;
  const int gt = blockIdx.x * 512 + ltid(wv), nth = gridDim.x * 512;
  for (int idx = gt; idx < NT * 64; idx += nth) {
    const int c8 = (idx & 63) * 8;
    const size_t off = (size_t)idx * 8;
    uint4 u = *(const uint4*)(ZS + off), a = *(const uint4*)(R0 + off), b = *(const uint4*)(R1 + off);
    float4 d0 = *(const float4*)(dsk + c8), d1 = *(const float4*)(dsk + c8 + 4);
    float y0 = gelu_tanh(bflo(u.x) * d0.x + bflo(a.x) + bflo(b.x)), y1 = gelu_tanh(bfhi(u.x) * d0.y + bfhi(a.x) + bfhi(b.x));
    float y2 = gelu_tanh(bflo(u.y) * d0.z + bflo(a.y) + bflo(b.y)), y3 = gelu_tanh(bfhi(u.y) * d0.w + bfhi(a.y) + bfhi(b.y));
    float y4 = gelu_tanh(bflo(u.z) * d1.x + bflo(a.z) + bflo(b.z)), y5 = gelu_tanh(bfhi(u.z) * d1.y + bfhi(a.z) + bfhi(b.z));
    float y6 = gelu_tanh(bflo(u.w) * d1.z + bflo(a.w) + bflo(b.w)), y7 = gelu_tanh(bfhi(u.w) * d1.w + bfhi(a.w) + bfhi(b.w));
    uint4 o; o.x = pack2(y0, y1); o.y = pack2(y2, y3); o.z = pack2(y4, y5); o.w = pack2(y6, y7);
    *(uint4*)(YS + off) = o;
  }
}

#define XB_TMO      128
#define XB_XCNT(j)  (256  + 64 * (j))
#define XB_XSUB(j)  (1280 + 64 * (j))
#define XB_XGEN(j)  (2304 + 64 * (j))
#define XB_TOP      3328
#define XB_TOPGEN   3392
#define XCD_BAR_WORDS 3456
#define XB_SPIN_CAP (1u << 18)
#define LAS __attribute__((address_space(3)))
__device__ __forceinline__ unsigned xb_ld(unsigned* p)              { return __hip_atomic_load(p, __ATOMIC_RELAXED, __HIP_MEMORY_SCOPE_AGENT); }
__device__ __forceinline__ unsigned xb_add(unsigned* p, unsigned v) { return __hip_atomic_fetch_add(p, v, __ATOMIC_RELAXED, __HIP_MEMORY_SCOPE_AGENT); }
__device__ __forceinline__ unsigned xb_xcc_id() { return (unsigned)__builtin_amdgcn_s_getreg((3 << 11) | 20) & 0xFu; }
#define XB_SPIN(cond, bar) do { unsigned _sp = 0; while (cond) { __builtin_amdgcn_s_sleep(1); \
    if ((++_sp & 255u) == 0u) { if (xb_ld(&(bar)[XB_TMO])) break; if (_sp > XB_SPIN_CAP) { atomicAdd(&(bar)[XB_TMO], 1u); break; } } } } while (0)
struct XcdBarrier { unsigned* bar; unsigned x; volatile LAS unsigned* st; };
__device__ __forceinline__ XcdBarrier xcd_barrier_post(unsigned* bar, volatile LAS unsigned* st) {
    XcdBarrier b; b.bar = bar; b.x = xb_xcc_id(); b.st = st;
    if (threadIdx.x == 0) (void)xb_add(&bar[XB_XCNT(b.x)], 1u);
    return b;
}
__device__ __forceinline__ void xcd_barrier_complete(unsigned* bar, unsigned x, unsigned& nloc, unsigned& nx) {
    const unsigned G = gridDim.x * gridDim.y * gridDim.z;
    unsigned sum, cnt, mine, sp = 0u;
    for (;;) {
        sum = 0u; cnt = 0u; mine = 0u;
#pragma unroll
        for (unsigned j = 0; j < 16; ++j) { const unsigned c = xb_ld(&bar[XB_XCNT(j)]); sum += c; cnt += (c > 0u) ? 1u : 0u; mine = (j == x) ? c : mine; }
        if (sum == G) break;
        __builtin_amdgcn_s_sleep(1);
        if ((++sp & 255u) == 0u) { if (xb_ld(&bar[XB_TMO])) break; if (sp > XB_SPIN_CAP) { atomicAdd(&bar[XB_TMO], 1u); break; } }
    }
    nloc = mine > 0u ? mine : 1u; nx = cnt > 0u ? cnt : 1u;
}
__device__ __forceinline__ void xcd_barrier(const XcdBarrier& b, int wv) {
    asm volatile("s_waitcnt vmcnt(0)" ::: "memory");
    __syncthreads();
    if (ltid(wv) == 0) {
        unsigned* bar = b.bar;
        unsigned bx = b.x; asm volatile("" : "+s"(bx));
        __builtin_amdgcn_s_waitcnt(0);
        unsigned nloc = b.st[0], nx = b.st[1];
        if (nloc == 0u) { xcd_barrier_complete(bar, bx, nloc, nx); b.st[0] = nloc; b.st[1] = nx; }
        const unsigned old = xb_add(&bar[XB_XSUB(bx)], 1u);
        const unsigned gen = old / nloc;
        if (old + 1u == (gen + 1u) * nloc) {
            __builtin_amdgcn_fence(__ATOMIC_RELEASE, "agent");
            asm volatile("s_waitcnt vmcnt(0)" ::: "memory");
            const unsigned og = xb_add(&bar[XB_TOP], 1u);
            const unsigned tg = og / nx;
            if (og + 1u == (tg + 1u) * nx) xb_add(&bar[XB_TOPGEN], 1u);
            else XB_SPIN(xb_ld(&bar[XB_TOPGEN]) == tg, bar);
            __builtin_amdgcn_fence(__ATOMIC_ACQUIRE, "agent");
            xb_add(&bar[XB_XGEN(bx)], 1u);
            asm volatile("s_waitcnt vmcnt(0)" ::: "memory");
        } else {
            XB_SPIN(xb_ld(&bar[XB_XGEN(bx)]) == gen, bar);
            __builtin_amdgcn_fence(__ATOMIC_ACQUIRE, "agent");
            asm volatile("s_waitcnt vmcnt(0)" ::: "memory");
        }
    }
    __syncthreads();
}

__global__ void __launch_bounds__(512) mega(Params p) {
  extern __shared__ __attribute__((aligned(16))) unsigned char shm[];
  cg::grid_group grid = cg::this_grid();
  unsigned char* ws = p.ws;
  u16* H = (u16*)(ws + OFF_H);
  float* CTXR = (float*)(ws + OFF_CTXR);
  const float* modv = (const float*)(ws + OFF_MODV);

  __shared__ uint4 xb_words;
  if (threadIdx.x == 0) xb_words = make_uint4(0u, 0u, 0u, 0u);
  __syncthreads();
  XcdBarrier xb; xb.bar = (unsigned*)(ws + OFF_BAR); xb.x = xb_xcc_id(); xb.st = (volatile LAS unsigned*)&xb_words;
  if (blockIdx.x == 0) { for (int i = threadIdx.x; i < XCD_BAR_WORDS; i += 512) xb.bar[i] = 0u; }
  const int wv = __builtin_amdgcn_readfirstlane((int)(threadIdx.x >> 6));
  phase_prep(p, shm, wv);
  grid.sync();
  if (threadIdx.x == 0) xb_words.w = xb_add(&xb.bar[XB_XCNT(xb.x)], 1u);

  phase_sh(p, wv);
  phase_norm(p, 0, 1, p.in[0], p.in[2], NT, wv);
  xcd_barrier(xb, wv);
  if (threadIdx.x == 0) {
    unsigned base = 0;
    for (unsigned jx = 0; jx < 16; ++jx) { const unsigned c = xb_ld(&xb.bar[XB_XCNT(jx)]); base += (jx < xb.x) ? c : 0u; }
    xb_words.z = base + xb_words.w;
  }
  __syncthreads();
  const int slot = __builtin_amdgcn_readfirstlane((int)xb_words.z);
  {
    const int nbk = (int)gridDim.x;
    int off = 0;
    for (int q = 0; q < 8; ++q) {
      const int li = q >> 1, lj = li >> 1;
      Epi es{}; es.xo = (float*)(ws + OFF_SHW) + (size_t)q * 33 * 4096;
      const u16* Aq = (const u16*)(ws + OFF_SH) + (size_t)q * 256 * 1024;
      const u16* Bq; int Nq;
      if (q & 1) { Bq = (const u16*)(ws + OFF_W1T) + (size_t)li * 4096 * 1024; Nq = 4096; }
      else if ((li & 1) == 0) { Bq = (const u16*)(ws + OFF_EVIN) + (size_t)lj * 1536 * 1024; Nq = 1536; }
      else { Bq = (const u16*)(ws + OFF_ODIN) + (size_t)lj * 3072 * 1024; Nq = 3072; }
      const int sl = (slot + nbk - (off % nbk)) % nbk;
      gemm_phase<EPI_F32>(Aq, 1024, Bq, 1024, 256, Nq, 1024, es, shm, wv, sl);
      off += Nq / 256;
    }
  }
  xcd_barrier(xb, wv);
  const float* STATS = (const float*)(ws + OFF_STATS);
  const float* SHW = (const float*)(ws + OFF_SHW);

  for (int i = 0; i < 4; ++i) {
    const bool last = (i == 3);
    const int j = i >> 1;
    const float* xsrc = (i == 0) ? p.in[0] : p.out;
    const float* csrc = (i == 0) ? p.in[2] : CTXR;
    const float* st1 = (i == 0) ? nullptr : STATS;
    const float* shw1 = SHW + (size_t)(i * 2) * 33 * 4096;
    Epi e{};
    if ((i & 1) == 0) {
      e = Epi{}; e.o16 = (u16*)(ws + R_ABT); e.o16b = (u16*)(ws + R_ABTC); e.stats = st1; e.shw = shw1;
      gemm_phase<EPI_FT>((const u16*)(ws + OFF_EVIN) + (size_t)j * 1536 * 1024, 1024, H, 1024, 1024, NT, 1024, e, shm, wv, slot);
      e = Epi{}; e.o16 = (u16*)(ws + R_ZS); e.ldo = 512; e.stats = st1; e.shw = shw1 + 1024;
      gemm_phase<EPI_STORE>(H, 1024, (const u16*)(ws + OFF_EVIN) + (size_t)j * 1536 * 1024 + 1024 * 1024, 1024, NT, 512, 1024, e, shm, wv, (int)gridDim.x - 1 - slot);
      xcd_barrier(xb, wv);
      e = Epi{}; e.o16 = (u16*)(ws + R_MIX); e.rowbase = 0; e.L = 2048;
      gemm_phase<EPI_FOUT>((const u16*)(ws + OFF_F2048), 4096, (const u16*)(ws + R_ABT), 4096, 2048, 16384, 4096, e, shm, wv, slot);
      e = Epi{}; e.o16 = (u16*)(ws + R_MIX); e.rowbase = NX; e.L = 256;
      gemm_phase<EPI_FOUT>((const u16*)(ws + OFF_F256), 512, (const u16*)(ws + R_ABTC), 512, 256, 16384, 512, e, shm, wv, slot);
      __syncthreads();
      phase_scan(p, j, shm, wv);
      xcd_barrier(xb, wv);
      e = Epi{}; e.o16 = (u16*)(ws + R_MIX); e.a16 = (const u16*)(ws + R_YS); e.bias = p.in[21] + j * 512;
      gemm_phase<EPI_GLU>((const u16*)(ws + R_YS), 512, (const u16*)(ws + OFF_GLU) + (size_t)j * 512 * 512, 512, NT, 512, 512, e, shm, wv, slot);
      xcd_barrier(xb, wv);
      e = Epi{}; e.xo = p.out; e.co = CTXR; e.xi = xsrc; e.ci = csrc; e.gate = modv + (size_t)i * 33 * 6144 + 2 * 1024;
      e.hout = H; e.stats_out = (float*)(ws + OFF_STATS); e.ngain = p.in[5] + i * 1024; e.nscale = modv + (size_t)i * 33 * 6144 + 4 * 1024;
      gemm_phase<EPI_RESID>((const u16*)(ws + R_MIX), 1024, (const u16*)(ws + OFF_EVOUT) + (size_t)j * 1024 * 1024, 1024, NT, 1024, 1024, e, shm, wv, slot);
    } else {
      e = Epi{}; e.o16 = (u16*)(ws + R_QKB); e.ldo = 2048; e.stats = st1; e.shw = shw1;
      gemm_phase<EPI_STORE>(H, 1024, (const u16*)(ws + OFF_ODIN) + (size_t)j * 3072 * 1024, 1024, NT, 2048, 1024, e, shm, wv, slot);
      xcd_barrier(xb, wv);
      e = Epi{}; e.o16 = (u16*)(ws + R_VT); e.stats = st1; e.shw = shw1 + 2048;
      if (slot & 1) phase_qknorm(p, j, wv);
      gemm_phase<EPI_VT>((const u16*)(ws + OFF_ODIN) + (size_t)j * 3072 * 1024 + (size_t)2048 * 1024, 1024, H, 1024, 1024, NT, 1024, e, shm, wv, (int)gridDim.x - 1 - slot);
      if (!(slot & 1)) { __syncthreads(); phase_qknorm(p, j, wv); }
      xcd_barrier(xb, wv);
      const float lam_init = 0.8f - 0.6f * expf(-0.3f * (float)i);
      phase_attn(p, j, lam_init, last, shm, wv, slot);
      xcd_barrier(xb, wv);
      e = Epi{}; e.xo = p.out; e.co = CTXR; e.xi = xsrc; e.ci = csrc; e.gate = modv + (size_t)i * 33 * 6144 + 2 * 1024;
      e.hout = H; e.stats_out = (float*)(ws + OFF_STATS); e.ngain = p.in[5] + i * 1024; e.nscale = modv + (size_t)i * 33 * 6144 + 4 * 1024;
      gemm_phase<EPI_RESID>((const u16*)(ws + R_MIX), 1024, (const u16*)(ws + OFF_ODOUT) + (size_t)j * 1024 * 1024, 1024, last ? NX : NT, 1024, 1024, e, shm, wv, slot);
    }
    xcd_barrier(xb, wv);
    const int nrows = last ? NX : NT;
    e = Epi{}; e.o16 = (u16*)(ws + R_HID); e.ldo = 4096; e.stats = STATS; e.shw = SHW + (size_t)(i * 2 + 1) * 33 * 4096;
    gemm_phase<EPI_SQRELU>(H, 1024, (const u16*)(ws + OFF_W1T) + (size_t)i * 4096 * 1024, 1024, nrows, 4096, 1024, e, shm, wv, slot);
    xcd_barrier(xb, wv);
    e = Epi{}; e.xo = p.out; e.co = CTXR; e.xi = p.out; e.ci = CTXR; e.gate = modv + (size_t)i * 33 * 6144 + 5 * 1024;
    if (!last) { e.hout = H; e.stats_out = (float*)(ws + OFF_STATS); e.ngain = p.in[4] + (i + 1) * 1024; e.nscale = modv + (size_t)(i + 1) * 33 * 6144 + 1 * 1024; }
    gemm_phase<EPI_RESID>((const u16*)(ws + R_HID), 4096, (const u16*)(ws + OFF_W2T) + (size_t)i * 4096 * 1024, 4096, nrows, 1024, 4096, e, shm, wv, slot);
    xcd_barrier(xb, wv);
  }
}

extern "C" void kernel_launch(void* const* d_in, const int* in_sizes, int n_in,
                              void* d_out, int out_size, void* d_ws, size_t ws_size,
                              hipStream_t stream) {
  static int grid_blocks = 0;
  if (!grid_blocks) {
    int dev = 0, cus = 0, per_cu = 0;
    (void)hipGetDevice(&dev);
    (void)hipDeviceGetAttribute(&cus, hipDeviceAttributeMultiprocessorCount, dev);
    (void)hipFuncSetAttribute((const void*)mega, hipFuncAttributeMaxDynamicSharedMemorySize, LDS_BYTES);
    (void)hipOccupancyMaxActiveBlocksPerMultiprocessor(&per_cu, (const void*)mega, 512, LDS_BYTES);
    if (per_cu < 1) per_cu = 1;
    grid_blocks = cus * per_cu;
    if (n_in != 28 || ws_size < WS_END) { fprintf(stderr, "kernel_launch: bad shapes n_in=%d ws=%zu\n", n_in, ws_size); grid_blocks = -1; }
  }
  if (grid_blocks < 0) return;
  Params p{};
  for (int i = 0; i < 28; ++i) p.in[i] = (const float*)d_in[i];
  p.out = (float*)d_out;
  p.ws = (unsigned char*)d_ws;
  void* args[] = {&p};
  hipError_t e = hipLaunchCooperativeKernel((void*)mega, dim3(grid_blocks), dim3(512), args, LDS_BYTES, stream);
  if (e != hipSuccess) fprintf(stderr, "cooperative launch failed: %s\n", hipGetErrorString(e));
}
```

```cpp
#include <hip/hip_runtime.h>
#include <hip/hip_bf16.h>
#include <hip/hip_cooperative_groups.h>
#include <cstdio>
namespace cg = cooperative_groups;

#define DI __device__ __forceinline__
typedef unsigned short u16;
using bf16x8 = __attribute__((ext_vector_type(8))) short;
using s16x4 = __attribute__((ext_vector_type(4))) short;
using f32x4 = __attribute__((ext_vector_type(4))) float;
using f32x16 = __attribute__((ext_vector_type(16))) float;
typedef __bf16 bf16x2_t __attribute__((ext_vector_type(2)));
typedef float f32x2_t __attribute__((ext_vector_type(2)));

DI unsigned pack2(float a, float b) {
  f32x2_t v = {a, b};
  bf16x2_t r = __builtin_convertvector(v, bf16x2_t);
  return __builtin_bit_cast(unsigned, r);
}
DI float bflo(unsigned u) { return __uint_as_float(u << 16); }
DI float bfhi(unsigned u) { return __uint_as_float(u & 0xffff0000u); }
DI u16 f2bf(float x) { return (u16)(pack2(x, 0.f) & 0xffffu); }
DI float shx(float v, int o, int lane) { return __int_as_float(__builtin_amdgcn_ds_bpermute((lane ^ o) << 2, __float_as_int(v))); }
DI float wave_sum(float v, int lane) {
#pragma unroll
  for (int o = 32; o >= 1; o >>= 1) v += shx(v, o, lane);
  return v;
}

DI const char* uptr(const void* p) {
  unsigned long long v = (unsigned long long)p;
  unsigned lo = __builtin_amdgcn_readfirstlane((unsigned)v), hi = __builtin_amdgcn_readfirstlane((unsigned)(v >> 32));
  return (const char*)(((unsigned long long)hi << 32) | lo);
}
DI int ltid(int wv) { int l; asm volatile("v_mbcnt_lo_u32_b32 %0, -1, 0\n\tv_mbcnt_hi_u32_b32 %0, -1, %0" : "=v"(l)); return wv * 64 + l; }

constexpr int NX = 65536;
constexpr int NC = 8192;
constexpr int NT = NX + NC;
constexpr size_t MiB = 1ull << 20;
constexpr size_t OFF_W1T = 0, OFF_W2T = 32 * MiB, OFF_EVIN = 64 * MiB, OFF_EVOUT = 70 * MiB, OFF_GLU = 74 * MiB,
                 OFF_ODIN = 75 * MiB, OFF_ODOUT = 87 * MiB, OFF_F2048 = 91 * MiB, OFF_F256 = 107 * MiB,
                 OFF_MODV = 108 * MiB, OFF_BAR = 111 * MiB + 512 * 1024, OFF_CTXR = 112 * MiB, OFF_H = 144 * MiB, OFF_R = 288 * MiB,
                 OFF_STATS = 864 * MiB, OFF_SHW = 869 * MiB, OFF_SH = 874 * MiB, WS_END = 878 * MiB;
constexpr size_t R_ABT = OFF_R, R_ABTC = OFF_R + 128 * MiB, R_ZS = OFF_R + 144 * MiB, R_R0 = OFF_R + 216 * MiB,
                 R_R1 = OFF_R + 288 * MiB, R_YS = OFF_R + 360 * MiB, R_MIX = OFF_R + 432 * MiB;
constexpr size_t R_QKB = OFF_R, R_VT = OFF_R + 288 * MiB, R_HID = OFF_R;
constexpr int LDS_BYTES = 131072;

struct Params {
  const float* in[28];
  float* out;
  unsigned char* ws;
};

constexpr int BM = 256, BK = 64, HALF = 128, HT = HALF * BK;
enum { EPI_STORE = 0, EPI_SQRELU = 1, EPI_RESID = 2, EPI_GLU = 3, EPI_FOUT = 4, EPI_TRANS_F = 5, EPI_TRANS_V = 6, EPI_F32 = 7, EPI_FT = 8, EPI_VT = 9 };

struct Epi {
  u16* o16;
  u16* o16b;
  const u16* a16;
  float* xo;
  float* co;
  const float* xi;
  const float* ci;
  const float* gate;
  const float* bias;
  int ldo;
  int rowbase;
  int L;
  const float* stats;
  const float* shw;
  u16* hout;
  float* stats_out;
  const float* ngain;
  const float* nscale;
};
DI float row_rinv(const float* stats, int r) {
  const float ssum = (stats[r] + stats[NT + r]) + (stats[2 * NT + r] + stats[3 * NT + r]);
  return rsqrtf(ssum * (1.f / 1024.f) + 1e-6f);
}
DI f32x4 row_rinv4(const float* stats, int r) {
  float4 a = *(const float4*)(stats + r), b = *(const float4*)(stats + NT + r), c = *(const float4*)(stats + 2 * NT + r), d = *(const float4*)(stats + 3 * NT + r);
  f32x4 o;
  o[0] = rsqrtf(((a.x + b.x) + (c.x + d.x)) * (1.f / 1024.f) + 1e-6f); o[1] = rsqrtf(((a.y + b.y) + (c.y + d.y)) * (1.f / 1024.f) + 1e-6f);
  o[2] = rsqrtf(((a.z + b.z) + (c.z + d.z)) * (1.f / 1024.f) + 1e-6f); o[3] = rsqrtf(((a.w + b.w) + (c.w + d.w)) * (1.f / 1024.f) + 1e-6f);
  return o;
}

DI int lds_byte(int r, int c) {
  int st = (r >> 4) * 2 + (c >> 5), rr = r & 15, cc = c & 31, ob = rr * 64 + cc * 2;
  return st * 1024 + (ob ^ (((ob >> 9) & 1) << 5));
}
DI void stage_rc(int b, int& R, int& C) {
  int st = b / 1024, sb = b % 1024, swz = sb ^ (((sb >> 9) & 1) << 5);
  R = (st >> 1) * 16 + swz / 64; C = (st & 1) * 32 + (swz % 64) / 2;
}

template <int EPI>
DI void epi4(const Epi& e, int r, int c, f32x4 v, f32x4 rinv4, float shv) {
  if constexpr (EPI == EPI_TRANS_F || EPI == EPI_TRANS_V) {
    if (e.stats) { v[0] = v[0] * rinv4[0] + shv; v[1] = v[1] * rinv4[1] + shv; v[2] = v[2] * rinv4[2] + shv; v[3] = v[3] * rinv4[3] + shv; }
  }
  if constexpr (EPI == EPI_STORE) {
    uint2 o; o.x = pack2(v[0], v[1]); o.y = pack2(v[2], v[3]);
    *(uint2*)(e.o16 + (size_t)r * e.ldo + c) = o;
  } else if constexpr (EPI == EPI_SQRELU) {
    float a0 = fmaxf(v[0], 0.f), a1 = fmaxf(v[1], 0.f), a2 = fmaxf(v[2], 0.f), a3 = fmaxf(v[3], 0.f);
    uint2 o; o.x = pack2(a0 * a0, a1 * a1); o.y = pack2(a2 * a2, a3 * a3);
    *(uint2*)(e.o16 + (size_t)r * e.ldo + c) = o;
  } else if constexpr (EPI == EPI_RESID) {
    const float* src; float* dst; int mrow;
    if (r < NX) { src = e.xi + (size_t)r * 1024 + c; dst = e.xo + (size_t)r * 1024 + c; mrow = r >> 11; }
    else { int rc = r - NX; src = e.ci + (size_t)rc * 1024 + c; dst = e.co + (size_t)rc * 1024 + c; mrow = 32; }
    float4 g = *(const float4*)(e.gate + (size_t)mrow * 6144 + c);
    float4 s = *(const float4*)src;
    float4 o; o.x = s.x + g.x * v[0]; o.y = s.y + g.y * v[1]; o.z = s.z + g.z * v[2]; o.w = s.w + g.w * v[3];
    *(float4*)dst = o;
  } else if constexpr (EPI == EPI_GLU) {
    uint2 y = *(const uint2*)(e.a16 + (size_t)r * 512 + c);
    float4 b = *(const float4*)(e.bias + c);
    float y0 = bflo(y.x), y1 = bfhi(y.x), y2 = bflo(y.y), y3 = bfhi(y.y);
    float s0 = 1.f / (1.f + __expf(-(v[0] + b.x))), s1 = 1.f / (1.f + __expf(-(v[1] + b.y)));
    float s2 = 1.f / (1.f + __expf(-(v[2] + b.z))), s3 = 1.f / (1.f + __expf(-(v[3] + b.w)));
    uint2 o; o.x = pack2(y0 * s0, y1 * s1); o.y = pack2(y2 * s2, y3 * s3);
    *(uint2*)(e.o16 + (size_t)r * 1024 + 512 + c) = o;
  } else if constexpr (EPI == EPI_FOUT) {
    int b = c >> 9, cc = c & 511;
    uint2 o; o.x = pack2(v[0], v[1]); o.y = pack2(v[2], v[3]);
    *(uint2*)(e.o16 + ((size_t)e.rowbase + (size_t)b * e.L + r) * 1024 + cc) = o;
  } else if constexpr (EPI == EPI_TRANS_F) {
    int part = c >> 9, jj = c & 511;
    uint2 o; o.x = pack2(v[0], v[1]); o.y = pack2(v[2], v[3]);
    if (r < NX) { int b = r >> 11, l = r & 2047; *(uint2*)(e.o16 + ((size_t)(b * 512 + jj)) * 4096 + part * 2048 + l) = o; }
    else { int rc = r - NX; int b = rc >> 8, l = rc & 255; *(uint2*)(e.o16b + ((size_t)(b * 512 + jj)) * 512 + part * 256 + l) = o; }
  } else if constexpr (EPI == EPI_TRANS_V) {
    uint2 o; o.x = pack2(v[0], v[1]); o.y = pack2(v[2], v[3]);
    int b, pos;
    if (r < NX) { b = r >> 11; pos = r & 2047; } else { int rc = r - NX; b = rc >> 8; pos = 2048 + (rc & 255); }
    pos = (pos & ~12) | ((pos & 4) << 1) | ((pos & 8) >> 1);
    *(uint2*)(e.o16 + ((size_t)(b * 1024 + c)) * 2304 + pos) = o;
  }
}

template <int EPI>
DI float epi8(const Epi& e, int r, int c, f32x4 v0, f32x4 v1, float rinv, float4 s0, float4 s1, float4 t0, float4 t1) {
  if constexpr (EPI == EPI_STORE || EPI == EPI_SQRELU) {
    if (e.stats) {
      v0[0] = v0[0] * rinv + s0.x; v0[1] = v0[1] * rinv + s0.y; v0[2] = v0[2] * rinv + s0.z; v0[3] = v0[3] * rinv + s0.w;
      v1[0] = v1[0] * rinv + s1.x; v1[1] = v1[1] * rinv + s1.y; v1[2] = v1[2] * rinv + s1.z; v1[3] = v1[3] * rinv + s1.w;
    }
  }
  if constexpr (EPI == EPI_F32) {
    if (r < 33) {
      float* d = e.xo + (size_t)r * 4096 + c;
      *(float4*)d = make_float4(v0[0], v0[1], v0[2], v0[3]); *(float4*)(d + 4) = make_float4(v1[0], v1[1], v1[2], v1[3]);
    }
  }
  if constexpr (EPI == EPI_STORE) {
    uint4 o; o.x = pack2(v0[0], v0[1]); o.y = pack2(v0[2], v0[3]); o.z = pack2(v1[0], v1[1]); o.w = pack2(v1[2], v1[3]);
    *(uint4*)(e.o16 + (size_t)r * e.ldo + c) = o;
  } else if constexpr (EPI == EPI_SQRELU) {
    float a0 = fmaxf(v0[0], 0.f), a1 = fmaxf(v0[1], 0.f), a2 = fmaxf(v0[2], 0.f), a3 = fmaxf(v0[3], 0.f);
    float a4 = fmaxf(v1[0], 0.f), a5 = fmaxf(v1[1], 0.f), a6 = fmaxf(v1[2], 0.f), a7 = fmaxf(v1[3], 0.f);
    uint4 o; o.x = pack2(a0 * a0, a1 * a1); o.y = pack2(a2 * a2, a3 * a3); o.z = pack2(a4 * a4, a5 * a5); o.w = pack2(a6 * a6, a7 * a7);
    *(uint4*)(e.o16 + (size_t)r * e.ldo + c) = o;
  } else if constexpr (EPI == EPI_RESID) {
    const float* src; float* dst;
    if (r < NX) { src = e.xi + (size_t)r * 1024 + c; dst = e.xo + (size_t)r * 1024 + c; }
    else { int rc = r - NX; src = e.ci + (size_t)rc * 1024 + c; dst = e.co + (size_t)rc * 1024 + c; }
    float4 x0 = *(const float4*)src, x1 = *(const float4*)(src + 4);
    float4 o0, o1;
    o0.x = x0.x + s0.x * v0[0]; o0.y = x0.y + s0.y * v0[1]; o0.z = x0.z + s0.z * v0[2]; o0.w = x0.w + s0.w * v0[3];
    o1.x = x1.x + s1.x * v1[0]; o1.y = x1.y + s1.y * v1[1]; o1.z = x1.z + s1.z * v1[2]; o1.w = x1.w + s1.w * v1[3];
    *(float4*)dst = o0; *(float4*)(dst + 4) = o1;
    if (e.hout) {
      uint4 h;
      h.x = pack2(o0.x * t0.x, o0.y * t0.y); h.y = pack2(o0.z * t0.z, o0.w * t0.w);
      h.z = pack2(o1.x * t1.x, o1.y * t1.y); h.w = pack2(o1.z * t1.z, o1.w * t1.w);
      *(uint4*)(e.hout + (size_t)r * 1024 + c) = h;
      return (o0.x * o0.x + o0.y * o0.y) + (o0.z * o0.z + o0.w * o0.w) + (o1.x * o1.x + o1.y * o1.y) + (o1.z * o1.z + o1.w * o1.w);
    }
  } else if constexpr (EPI == EPI_GLU) {
    uint4 y = *(const uint4*)(e.a16 + (size_t)r * 512 + c);
    float g0 = 1.f / (1.f + __expf(-(v0[0] + s0.x))), g1 = 1.f / (1.f + __expf(-(v0[1] + s0.y)));
    float g2 = 1.f / (1.f + __expf(-(v0[2] + s0.z))), g3 = 1.f / (1.f + __expf(-(v0[3] + s0.w)));
    float g4 = 1.f / (1.f + __expf(-(v1[0] + s1.x))), g5 = 1.f / (1.f + __expf(-(v1[1] + s1.y)));
    float g6 = 1.f / (1.f + __expf(-(v1[2] + s1.z))), g7 = 1.f / (1.f + __expf(-(v1[3] + s1.w)));
    uint4 o; o.x = pack2(bflo(y.x) * g0, bfhi(y.x) * g1); o.y = pack2(bflo(y.y) * g2, bfhi(y.y) * g3);
    o.z = pack2(bflo(y.z) * g4, bfhi(y.z) * g5); o.w = pack2(bflo(y.w) * g6, bfhi(y.w) * g7);
    *(uint4*)(e.o16 + (size_t)r * 1024 + 512 + c) = o;
  } else if constexpr (EPI == EPI_FT || EPI == EPI_VT) {
    if (e.stats) {
      v0[0] = v0[0] * s0.x + rinv; v0[1] = v0[1] * s0.y + rinv; v0[2] = v0[2] * s0.z + rinv; v0[3] = v0[3] * s0.w + rinv;
      v1[0] = v1[0] * s1.x + rinv; v1[1] = v1[1] * s1.y + rinv; v1[2] = v1[2] * s1.z + rinv; v1[3] = v1[3] * s1.w + rinv;
    }
    int b, pos;
    if (c < NX) { b = c >> 11; pos = c & 2047; } else { const int rc = c - NX; b = rc >> 8; pos = rc & 255; }
    if constexpr (EPI == EPI_FT) {
      const int part = r >> 9, jj = r & 511;
      uint4 o; o.x = pack2(v0[0], v0[1]); o.y = pack2(v0[2], v0[3]); o.z = pack2(v1[0], v1[1]); o.w = pack2(v1[2], v1[3]);
      if (c < NX) *(uint4*)(e.o16 + ((size_t)(b * 512 + jj)) * 4096 + part * 2048 + pos) = o;
      else *(uint4*)(e.o16b + ((size_t)(b * 512 + jj)) * 512 + part * 256 + pos) = o;
    } else {
      if (c >= NX) pos += 2048;
      const int p0 = (pos & ~12) | ((pos & 4) << 1) | ((pos & 8) >> 1);
      const int q1 = pos + 4, p1 = (q1 & ~12) | ((q1 & 4) << 1) | ((q1 & 8) >> 1);
      u16* dst = e.o16 + ((size_t)(b * 1024 + r)) * 2304;
      uint2 oa; oa.x = pack2(v0[0], v0[1]); oa.y = pack2(v0[2], v0[3]);
      uint2 ob; ob.x = pack2(v1[0], v1[1]); ob.y = pack2(v1[2], v1[3]);
      *(uint2*)(dst + p0) = oa; *(uint2*)(dst + p1) = ob;
    }
  } else if constexpr (EPI == EPI_FOUT) {
    int b = c >> 9, cc = c & 511;
    uint4 o; o.x = pack2(v0[0], v0[1]); o.y = pack2(v0[2], v0[3]); o.z = pack2(v1[0], v1[1]); o.w = pack2(v1[2], v1[3]);
    *(uint4*)(e.o16 + ((size_t)e.rowbase + (size_t)b * e.L + r) * 1024 + cc) = o;
  }
  return 0.f;
}

DI int gemm_decode(int T, int nsuper, int nNs, int SWM, int SWN, int nM, int& pm, int& pn) {
  const int sup = T >> 5, within = T & 31;
  if (sup >= nsuper) return -1;
  const int mg = sup / nNs, ng = sup - mg * nNs;
  pm = mg * SWM + within / SWN; pn = ng * SWN + within % SWN;
  return pm < nM ? 1 : 0;
}

template <int EPI>
DI void gemm_phase(const u16* __restrict__ A, int lda, const u16* __restrict__ Bt, int ldb,
                   int M, int N, int K, const Epi& e, unsigned char* shmraw, int wv, int slot) {
  constexpr bool SWAP = (EPI != EPI_TRANS_F && EPI != EPI_TRANS_V);
  u16* shm = (u16*)shmraw;
  const int tidx = ltid(wv);
#define SA(b, h) (shm + ((b) * 2 + (h)) * HT)
#define SB(b, h) (shm + (4 + (b) * 2 + (h)) * HT)
#define STAGEA(P, br, kt) do { const char* _g = uptr(A + (size_t)(br) * lda + (size_t)(kt) * BK); \
    _Pragma("unroll") for (int _i = 0; _i < 2; ++_i) { \
      __builtin_amdgcn_global_load_lds((const unsigned*)(_g + offA[_i]), (unsigned*)((char*)(P) + tidx * 16 + _i * 8192), 16, 0, 0); } } while (0)
#define STAGEB(P, br, kt) do { const char* _g = uptr(Bt + (size_t)(br) * ldb + (size_t)(kt) * BK); \
    _Pragma("unroll") for (int _i = 0; _i < 2; ++_i) { \
      __builtin_amdgcn_global_load_lds((const unsigned*)(_g + offB[_i]), (unsigned*)((char*)(P) + tidx * 16 + _i * 8192), 16, 0, 0); } } while (0)
#define LDA(dst, b, h) _Pragma("unroll") for (int m = 0; m < 4; ++m) _Pragma("unroll") for (int k = 0; k < 2; ++k) \
    dst[m][k] = *reinterpret_cast<const bf16x8*>((char*)SA(b, h) + aoff + m * 2048 + k * 1024)
#define LDB(dst, b, h) _Pragma("unroll") for (int n = 0; n < 2; ++n) _Pragma("unroll") for (int k = 0; k < 2; ++k) \
    dst[n][k] = *reinterpret_cast<const bf16x8*>((char*)SB(b, h) + boff + n * (SWAP ? 256 : 2048) + k * 1024)
#define MMA(ai, bj, AT, BT) do { __builtin_amdgcn_s_setprio(1); \
    _Pragma("unroll") for (int m = 0; m < 4; ++m) _Pragma("unroll") for (int n = 0; n < 2; ++n) _Pragma("unroll") for (int k = 0; k < 2; ++k) { \
      if constexpr (SWAP) acc[ai][bj][m][n] = __builtin_amdgcn_mfma_f32_16x16x32_bf16(BT[n][k], AT[m][k], acc[ai][bj][m][n], 0, 0, 0); \
      else acc[ai][bj][m][n] = __builtin_amdgcn_mfma_f32_16x16x32_bf16(AT[m][k], BT[n][k], acc[ai][bj][m][n], 0, 0, 0); } \
    __builtin_amdgcn_s_setprio(0); } while (0)
#define WAIT_V(n) asm volatile("s_waitcnt vmcnt(" #n ")" ::: "memory")
#define WAIT_L(n) asm volatile("s_waitcnt lgkmcnt(" #n ")" ::: "memory")
#define BAR __builtin_amdgcn_s_barrier()
#define SCHED __builtin_amdgcn_sched_barrier(0)

  const int nM = M / BM, nN = N / BM;
  int SWN = nN < 4 ? nN : 4, SWM = 32 / SWN;
  if (nM < 8) { SWM = 1; SWN = nN < 32 ? nN : 32; }
  if (nM == 4 && (nN & 7) == 0) { SWM = 4; SWN = 8; }
  const int nNs = nN / SWN, nMs = (nM + SWM - 1) / SWM;
  const int nsuper = nNs * nMs;
  const int nb = gridDim.x;
  const int wid = tidx >> 6, lane = tidx & 63, wr = wid >> 2, wc = wid & 3, fr = lane & 15, fq = lane >> 4;
  const int aoff = lds_byte(wr * 64 + fr, fq * 8);
  const int boff = lds_byte(wc * 32 + (SWAP ? ((fr >> 2) * 8 + (fr & 3)) : fr), fq * 8);
  unsigned offA[2], offB[2];
#pragma unroll
  for (int i = 0; i < 2; ++i) { int r_, c_; stage_rc(tidx * 16 + i * 8192, r_, c_); offA[i] = (unsigned)(r_ * lda + c_) * 2u; offB[i] = (unsigned)(r_ * ldb + c_) * 2u; }
  const int nt = K / BK;

  int T = slot, pm = 0, pn = 0, st_;
  while ((st_ = gemm_decode(T, nsuper, nNs, SWM, SWN, nM, pm, pn)) == 0) T += nb;
  if (st_ < 0) return;
#define PROLOGUE_STAGES(br_, bc_) do { \
    STAGEB(SB(0, 0), bc_, 0); STAGEA(SA(0, 0), br_, 0); STAGEB(SB(0, 1), (bc_) + HALF, 0); STAGEA(SA(0, 1), (br_) + HALF, 0); \
    STAGEB(SB(1, 0), bc_, 1); STAGEA(SA(1, 0), br_, 1); STAGEB(SB(1, 1), (bc_) + HALF, 1); } while (0)
  PROLOGUE_STAGES(pm * BM, pn * BM);
  bool first_tile = true;
  for (;;) {
    const int brow = pm * BM, bcol = pn * BM;
    int pm2 = 0, pn2 = 0, st2;
    T += nb;
    while ((st2 = gemm_decode(T, nsuper, nNs, SWM, SWN, nM, pm2, pn2)) == 0) T += nb;
    f32x4 acc[2][2][4][2];
#pragma unroll
    for (int a = 0; a < 2; ++a)
#pragma unroll
      for (int b = 0; b < 2; ++b)
#pragma unroll
        for (int m = 0; m < 4; ++m)
#pragma unroll
          for (int n = 0; n < 2; ++n) acc[a][b][m][n] = f32x4{0.f, 0.f, 0.f, 0.f};
    bf16x8 At[4][2], B0[2][2], B1[2][2];
    if (first_tile) WAIT_V(0);
    else if constexpr (EPI == EPI_STORE || EPI == EPI_SQRELU || EPI == EPI_GLU || EPI == EPI_FOUT || EPI == EPI_FT) WAIT_V(16);
    else if constexpr (EPI == EPI_TRANS_F || EPI == EPI_TRANS_V || EPI == EPI_VT) WAIT_V(32);
    else if constexpr (EPI == EPI_RESID) { if (e.hout) WAIT_V(48); else WAIT_V(32); }
    else WAIT_V(0);
    first_tile = false;
    if (wr == 1) BAR;
    BAR;
    for (int t = 0; t < nt - 2; t += 2) {
      LDB(B0, 0, 0); SCHED; LDA(At, 0, 0); STAGEA(SA(1, 1), brow + HALF, t + 1);
      WAIT_L(8); BAR; WAIT_L(0); MMA(0, 0, At, B0); BAR; SCHED;
      LDB(B1, 0, 1); STAGEB(SB(0, 0), bcol, t + 2);
      BAR; WAIT_L(0); MMA(0, 1, At, B1); BAR;
      LDA(At, 0, 1); STAGEA(SA(0, 0), brow, t + 2);
      BAR; WAIT_L(0); MMA(1, 0, At, B0); BAR; SCHED;
      STAGEB(SB(0, 1), bcol + HALF, t + 2);
      WAIT_V(6); BAR; MMA(1, 1, At, B1); BAR;
      LDB(B0, 1, 0); SCHED; LDA(At, 1, 0); STAGEA(SA(0, 1), brow + HALF, t + 2);
      WAIT_L(8); BAR; WAIT_L(0); MMA(0, 0, At, B0); BAR; SCHED;
      LDB(B1, 1, 1); STAGEB(SB(1, 0), bcol, t + 3);
      BAR; WAIT_L(0); MMA(0, 1, At, B1); BAR;
      LDA(At, 1, 1); STAGEA(SA(1, 0), brow, t + 3);
      BAR; WAIT_L(0); MMA(1, 0, At, B0); BAR; SCHED;
      STAGEB(SB(1, 1), bcol + HALF, t + 3);
      WAIT_V(6); BAR; MMA(1, 1, At, B1); BAR;
    }
    { LDB(B0, 0, 0); LDA(At, 0, 0); STAGEA(SA(1, 1), brow + HALF, nt - 1);
      BAR; WAIT_L(0); MMA(0, 0, At, B0); BAR;
      LDB(B1, 0, 1); BAR; WAIT_L(0); MMA(0, 1, At, B1); BAR;
      LDA(At, 0, 1); WAIT_V(4); BAR; WAIT_L(0); MMA(1, 0, At, B0); MMA(1, 1, At, B1); BAR; }
    { LDB(B0, 1, 0); LDA(At, 1, 0); WAIT_V(2); BAR; WAIT_L(0); MMA(0, 0, At, B0); BAR;
      LDB(B1, 1, 1); WAIT_V(0); BAR; WAIT_L(0); MMA(0, 1, At, B1); BAR;
      LDA(At, 1, 1); BAR; WAIT_L(0); MMA(1, 0, At, B0); MMA(1, 1, At, B1); BAR; }
    if (wr == 0) BAR;
    if (st2 > 0) PROLOGUE_STAGES(pm2 * BM, pn2 * BM);
    asm volatile("" ::: "memory");
    const int t2_ = ltid(wv); const int wid2 = t2_ >> 6, lane2 = t2_ & 63, wr2 = wid2 >> 2, wc2 = wid2 & 3, fr2 = lane2 & 15, fq2 = lane2 >> 4;
    const int tokbase_t = (EPI == EPI_FT || EPI == EPI_VT) ? bcol : brow;
    const int mrow_t = (tokbase_t < NX) ? (tokbase_t >> 11) : 32;
    if constexpr (SWAP) {
      float4 cs[2][2], ct[2][2];
#pragma unroll
      for (int bj = 0; bj < 2; ++bj) {
        const int c = bcol + bj * HALF + wc2 * 32 + fq2 * 8;
        cs[bj][0] = cs[bj][1] = ct[bj][0] = ct[bj][1] = make_float4(0.f, 0.f, 0.f, 0.f);
        if constexpr (EPI == EPI_FT || EPI == EPI_VT) {
          if (e.stats) { f32x4 ra = row_rinv4(e.stats, c), rb = row_rinv4(e.stats, c + 4); cs[bj][0] = make_float4(ra[0], ra[1], ra[2], ra[3]); cs[bj][1] = make_float4(rb[0], rb[1], rb[2], rb[3]); }
        } else if constexpr (EPI == EPI_STORE || EPI == EPI_SQRELU) {
          if (e.stats) { const float* sp = e.shw + (size_t)mrow_t * 4096 + c; cs[bj][0] = *(const float4*)sp; cs[bj][1] = *(const float4*)(sp + 4); }
        } else if constexpr (EPI == EPI_RESID) {
          const float* gp = e.gate + (size_t)mrow_t * 6144 + c; cs[bj][0] = *(const float4*)gp; cs[bj][1] = *(const float4*)(gp + 4);
          if (e.hout) {
            const float* np = e.ngain + c; const float* scp = e.nscale + (size_t)mrow_t * 6144 + c;
            float4 n0 = *(const float4*)np, n1 = *(const float4*)(np + 4), c0 = *(const float4*)scp, c1 = *(const float4*)(scp + 4);
            ct[bj][0] = make_float4(n0.x * (1.f + c0.x), n0.y * (1.f + c0.y), n0.z * (1.f + c0.z), n0.w * (1.f + c0.w));
            ct[bj][1] = make_float4(n1.x * (1.f + c1.x), n1.y * (1.f + c1.y), n1.z * (1.f + c1.z), n1.w * (1.f + c1.w));
          }
        } else if constexpr (EPI == EPI_GLU) {
          cs[bj][0] = *(const float4*)(e.bias + c); cs[bj][1] = *(const float4*)(e.bias + c + 4);
        }
      }
      float rowss[2][4];
#pragma unroll
      for (int ai = 0; ai < 2; ++ai)
#pragma unroll
        for (int m = 0; m < 4; ++m) {
          const int row = brow + ai * HALF + wr2 * 64 + m * 16 + fr2;
          float rinv = 1.f;
          if constexpr (EPI == EPI_STORE || EPI == EPI_SQRELU) { if (e.stats) rinv = row_rinv(e.stats, row); }
          if constexpr (EPI == EPI_FT || EPI == EPI_VT) { rinv = e.stats ? e.shw[(size_t)mrow_t * 4096 + row] : 0.f; }
          float ss = 0.f;
#pragma unroll
          for (int bj = 0; bj < 2; ++bj)
            ss += epi8<EPI>(e, row, bcol + bj * HALF + wc2 * 32 + fq2 * 8, acc[ai][bj][m][0], acc[ai][bj][m][1], rinv, cs[bj][0], cs[bj][1], ct[bj][0], ct[bj][1]);
          rowss[ai][m] = ss;
        }
      if constexpr (EPI == EPI_RESID) {
        if (e.hout) {
          float* red = (float*)SA(1, 1);
#pragma unroll
          for (int ai = 0; ai < 2; ++ai)
#pragma unroll
            for (int m = 0; m < 4; ++m) {
              float v = rowss[ai][m];
              v += shx(v, 16, lane2); v += shx(v, 32, lane2);
              if (fq2 == 0) red[(ai * HALF + wr2 * 64 + m * 16 + fr2) * 4 + wc2] = v;
            }
          WAIT_L(0); BAR;
          if (t2_ < 256) {
            float4 q = *(const float4*)(red + t2_ * 4);
            e.stats_out[(size_t)pn * NT + brow + t2_] = (q.x + q.y) + (q.z + q.w);
          }
        }
      }
    } else {
      float shv[2][2];
#pragma unroll
      for (int bj = 0; bj < 2; ++bj)
#pragma unroll
        for (int n = 0; n < 2; ++n) shv[bj][n] = e.stats ? e.shw[(size_t)mrow_t * 4096 + bcol + bj * HALF + wc2 * 32 + n * 16 + fr2] : 0.f;
#pragma unroll
      for (int ai = 0; ai < 2; ++ai)
#pragma unroll
        for (int m = 0; m < 4; ++m) {
          const int row4 = brow + ai * HALF + wr2 * 64 + m * 16 + fq2 * 4;
          f32x4 rinv4 = {1.f, 1.f, 1.f, 1.f};
          if (e.stats) rinv4 = row_rinv4(e.stats, row4);
#pragma unroll
          for (int bj = 0; bj < 2; ++bj)
#pragma unroll
            for (int n = 0; n < 2; ++n) epi4<EPI>(e, row4, bcol + bj * HALF + wc2 * 32 + n * 16 + fr2, acc[ai][bj][m][n], rinv4, shv[bj][n]);
        }
    }
    if (st2 < 0) break;
    pm = pm2; pn = pn2;
  }
  WAIT_V(0);
#undef PROLOGUE_STAGES
#undef SA
#undef SB
#undef STAGEA
#undef STAGEB
#undef LDA
#undef LDB
#undef MMA
}

DI void transpose_mat(const float* __restrict__ src, int ldn, int n0, int K, int N, u16* __restrict__ dst, float* lds, int wv) {
  const int tilesN = N / 64, ntile = (K / 64) * tilesN, tid = ltid(wv);
  for (int t = blockIdx.x; t < ntile; t += gridDim.x) {
    const int tk = t / tilesN, tn = t - tk * tilesN, k0 = tk * 64, nn0 = tn * 64;
    const int r = tid >> 4, c4 = (tid & 15) * 4;
#pragma unroll
    for (int i = 0; i < 2; ++i) {
      int rr = r + 32 * i;
      float4 v = *(const float4*)(src + (size_t)(k0 + rr) * ldn + n0 + nn0 + c4);
      lds[rr * 65 + c4 + 0] = v.x; lds[rr * 65 + c4 + 1] = v.y; lds[rr * 65 + c4 + 2] = v.z; lds[rr * 65 + c4 + 3] = v.w;
    }
    __syncthreads();
    const int n = tid >> 3, kc = (tid & 7) * 8;
    uint4 o;
    o.x = pack2(lds[(kc + 0) * 65 + n], lds[(kc + 1) * 65 + n]);
    o.y = pack2(lds[(kc + 2) * 65 + n], lds[(kc + 3) * 65 + n]);
    o.z = pack2(lds[(kc + 4) * 65 + n], lds[(kc + 5) * 65 + n]);
    o.w = pack2(lds[(kc + 6) * 65 + n], lds[(kc + 7) * 65 + n]);
    *(uint4*)(dst + (size_t)(nn0 + n) * K + k0 + kc) = o;
    __syncthreads();
  }
}

DI void phase_prep(const Params& p, unsigned char* shm, int wv) {
  float* lds = (float*)shm;
  unsigned char* ws = p.ws;
  const int tid = ltid(wv), lane = tid & 63, w = tid >> 6;
  for (int i = 0; i < 4; ++i) {
    transpose_mat(p.in[8] + (size_t)i * 1024 * 4096, 4096, 0, 1024, 4096, (u16*)(ws + OFF_W1T) + (size_t)i * 4096 * 1024, lds, wv);
    transpose_mat(p.in[9] + (size_t)i * 4096 * 1024, 1024, 0, 4096, 1024, (u16*)(ws + OFF_W2T) + (size_t)i * 4096 * 1024, lds, wv);
  }
  for (int j = 0; j < 2; ++j) {
    transpose_mat(p.in[10] + (size_t)j * 1024 * 1024, 1024, 512, 1024, 512, (u16*)(ws + OFF_EVIN) + (size_t)j * 1536 * 1024 + 1024 * 1024, lds, wv);
    transpose_mat(p.in[11] + (size_t)j * 1024 * 1024, 1024, 0, 1024, 1024, (u16*)(ws + OFF_EVOUT) + (size_t)j * 1024 * 1024, lds, wv);
    transpose_mat(p.in[20] + (size_t)j * 512 * 512, 512, 0, 512, 512, (u16*)(ws + OFF_GLU) + (size_t)j * 512 * 512, lds, wv);
    transpose_mat(p.in[22] + (size_t)j * 1024 * 3072, 3072, 0, 1024, 3072, (u16*)(ws + OFF_ODIN) + (size_t)j * 3072 * 1024, lds, wv);
    transpose_mat(p.in[23] + (size_t)j * 1024 * 1024, 1024, 0, 1024, 1024, (u16*)(ws + OFF_ODOUT) + (size_t)j * 1024 * 1024, lds, wv);
  }
  for (int t = blockIdx.x; t < 128; t += gridDim.x) {
    const int j = t >> 6, g = (t >> 4) & 3, k0 = (t & 15) * 64;
    float* wl = lds; float* tab = lds + 8192;
    __syncthreads();
#pragma unroll
    for (int i = 0; i < 16; ++i) {
      int idx = tid + 512 * i, kk = idx >> 7, c = idx & 127;
      wl[idx] = p.in[10][((size_t)j * 1024 + k0 + kk) * 1024 + g * 128 + c];
    }
    if (tid < 128) { tab[tid] = cospif(tid * (1.f / 64.f)); tab[128 + tid] = sinpif(tid * (1.f / 64.f)); }
    __syncthreads();
    const int pc = tid & 255, part = pc >> 7, cp = pc & 127, kh = tid >> 8;
    float acc[32];
#pragma unroll
    for (int kk = 0; kk < 32; ++kk) acc[kk] = 0.f;
    for (int c = 0; c < 128; ++c) {
      const float tv = tab[part * 128 + ((c * cp) & 127)];
#pragma unroll
      for (int kk = 0; kk < 32; ++kk) acc[kk] += wl[(kh * 32 + kk) * 128 + c] * tv;
    }
    const float sc = 0.08838834764831845f;
    u16* dst = (u16*)(ws + OFF_EVIN) + (size_t)j * 1536 * 1024 + (size_t)(part * 512 + g * 128 + cp) * 1024 + k0 + kh * 32;
#pragma unroll
    for (int q = 0; q < 4; ++q) {
      uint4 o;
      o.x = pack2(acc[q * 8 + 0] * sc, acc[q * 8 + 1] * sc); o.y = pack2(acc[q * 8 + 2] * sc, acc[q * 8 + 3] * sc);
      o.z = pack2(acc[q * 8 + 4] * sc, acc[q * 8 + 5] * sc); o.w = pack2(acc[q * 8 + 6] * sc, acc[q * 8 + 7] * sc);
      *(uint4*)(dst + q * 8) = o;
    }
  }
  {
    const int gt = blockIdx.x * 512 + tid, nth = gridDim.x * 512;
    u16* F = (u16*)(ws + OFF_F2048);
    const float s = 0.022097086912079608f;
    for (int idx = gt; idx < 2048 * 512; idx += nth) {
      const int lp = idx >> 9, k8 = (idx & 511) * 8;
      float v[8];
#pragma unroll
      for (int jj = 0; jj < 8; ++jj) {
        int k = k8 + jj;
        if (k < 2048) { int m = (k * lp) & 2047; v[jj] = cospif(m * (1.f / 1024.f)) * s; }
        else { int m = ((k - 2048) * lp) & 2047; v[jj] = -sinpif(m * (1.f / 1024.f)) * s; }
      }
      uint4 o; o.x = pack2(v[0], v[1]); o.y = pack2(v[2], v[3]); o.z = pack2(v[4], v[5]); o.w = pack2(v[6], v[7]);
      *(uint4*)(F + (size_t)lp * 4096 + k8) = o;
    }
    u16* F2 = (u16*)(ws + OFF_F256);
    for (int idx = gt; idx < 256 * 64; idx += nth) {
      const int lp = idx >> 6, k8 = (idx & 63) * 8;
      float v[8];
#pragma unroll
      for (int jj = 0; jj < 8; ++jj) {
        int k = k8 + jj;
        if (k < 256) { int m = (k * lp) & 255; v[jj] = cospif(m * (1.f / 128.f)) * 0.0625f; }
        else { int m = ((k - 256) * lp) & 255; v[jj] = -sinpif(m * (1.f / 128.f)) * 0.0625f; }
      }
      uint4 o; o.x = pack2(v[0], v[1]); o.y = pack2(v[2], v[3]); o.z = pack2(v[4], v[5]); o.w = pack2(v[6], v[7]);
      *(uint4*)(F2 + (size_t)lp * 512 + k8) = o;
    }
  }
  {
    float* modv = (float*)(ws + OFF_MODV);
    float* sl = lds + w * (33 * 64);
    float* red = lds;
    for (int t = blockIdx.x; t < 384; t += gridDim.x) {
      const int i = t / 96, n0 = (t % 96) * 64, n = n0 + lane;
      float acc[33];
#pragma unroll
      for (int r = 0; r < 33; ++r) acc[r] = 0.f;
      const float* wbase = p.in[6] + (size_t)i * 1024 * 6144 + n;
      __syncthreads();
      for (int half = 0; half < 2; ++half) {
        const int kbase = w * 128 + half * 64;
        __builtin_amdgcn_wave_barrier();
#pragma unroll
        for (int r = 0; r < 33; ++r) {
          const float cv = (r < 32) ? p.in[1][r * 1024 + kbase + lane] : p.in[3][kbase + lane];
          sl[r * 64 + lane] = cv / (1.f + __expf(-cv));
        }
        __builtin_amdgcn_wave_barrier();
        for (int k = 0; k < 64; k += 16) {
          float wv16[16];
#pragma unroll
          for (int u = 0; u < 16; ++u) wv16[u] = wbase[(size_t)(kbase + k + u) * 6144];
#pragma unroll
          for (int r = 0; r < 33; ++r) {
            const float* sp = sl + r * 64 + k;
            float4 s0 = *(const float4*)sp, s1 = *(const float4*)(sp + 4), s2 = *(const float4*)(sp + 8), s3 = *(const float4*)(sp + 12);
            acc[r] += s0.x * wv16[0] + s0.y * wv16[1] + s0.z * wv16[2] + s0.w * wv16[3] + s1.x * wv16[4] + s1.y * wv16[5] + s1.z * wv16[6] + s1.w * wv16[7]
                    + s2.x * wv16[8] + s2.y * wv16[9] + s2.z * wv16[10] + s2.w * wv16[11] + s3.x * wv16[12] + s3.y * wv16[13] + s3.z * wv16[14] + s3.w * wv16[15];
          }
        }
      }
      __syncthreads();
#pragma unroll
      for (int r = 0; r < 33; ++r) red[(w * 33 + r) * 64 + lane] = acc[r];
      __syncthreads();
      for (int o = tid; o < 33 * 64; o += 512) {
        const int r = o >> 6, c = o & 63;
        float sum = 0.f;
#pragma unroll
        for (int ww = 0; ww < 8; ++ww) sum += red[(ww * 33 + r) * 64 + c];
        modv[((size_t)i * 33 + r) * 6144 + n0 + c] = sum + p.in[7][i * 6144 + n0 + c];
      }
    }
  }
}

DI void phase_sh(const Params& p, int wv) {
  const float* modv = (const float*)(p.ws + OFF_MODV);
  u16* SH = (u16*)(p.ws + OFF_SH);
  const int gt = blockIdx.x * 512 + ltid(wv), nth = gridDim.x * 512;
  for (int idx = gt; idx < 8 * 33 * 128; idx += nth) {
    const int q = idx / (33 * 128), rem = idx - q * (33 * 128), r = rem >> 7, k8 = (rem & 127) * 8;
    const int i = q >> 1, chunk = (q & 1) ? 3 : 0;
    const float* src = modv + ((size_t)i * 33 + r) * 6144 + chunk * 1024 + k8;
    float4 a = *(const float4*)src, b = *(const float4*)(src + 4);
    uint4 o; o.x = pack2(a.x, a.y); o.y = pack2(a.z, a.w); o.z = pack2(b.x, b.y); o.w = pack2(b.z, b.w);
    *(uint4*)(SH + ((size_t)q * 256 + r) * 1024 + k8) = o;
  }
}

DI void phase_norm(const Params& p, int layer, int which, const float* xsrc, const float* csrc, int nrows, int wv) {
  const int tid = ltid(wv); const int lane = tid & 63, w = tid >> 6;
  const float* g = p.in[which == 1 ? 4 : 5] + layer * 1024;
  const float* modv = (const float*)(p.ws + OFF_MODV) + (size_t)layer * 33 * 6144;
  u16* H = (u16*)(p.ws + OFF_H);
  const int shc = (which == 1 ? 0 : 3) * 1024, scc = (which == 1 ? 1 : 4) * 1024;
  const int rstride = gridDim.x * 8;
  int row = blockIdx.x * 8 + w;
  float4 nv[4];
  if (row < nrows) {
    const float* src = (row < NX) ? xsrc + (size_t)row * 1024 : csrc + (size_t)(row - NX) * 1024;
#pragma unroll
    for (int i = 0; i < 4; ++i) nv[i] = *(const float4*)(src + (lane + 64 * i) * 4);
  }
  for (; row < nrows; row += rstride) {
    const int mrow = (row < NX) ? (row >> 11) : 32;
    const float* mv = modv + (size_t)mrow * 6144;
    float4 v[4]; float ss = 0.f;
#pragma unroll
    for (int i = 0; i < 4; ++i) { v[i] = nv[i]; ss += v[i].x * v[i].x + v[i].y * v[i].y + v[i].z * v[i].z + v[i].w * v[i].w; }
    const int nrow = row + rstride;
    if (nrow < nrows) {
      const float* src = (nrow < NX) ? xsrc + (size_t)nrow * 1024 : csrc + (size_t)(nrow - NX) * 1024;
#pragma unroll
      for (int i = 0; i < 4; ++i) nv[i] = *(const float4*)(src + (lane + 64 * i) * 4);
    }
    ss = wave_sum(ss, lane);
    const float rinv = rsqrtf(ss * (1.f / 1024.f) + 1e-6f);
#pragma unroll
    for (int i = 0; i < 4; ++i) {
      const int col = (lane + 64 * i) * 4;
      float4 gg = *(const float4*)(g + col), sc = *(const float4*)(mv + scc + col), sh = *(const float4*)(mv + shc + col);
      float y0 = v[i].x * rinv * gg.x * (1.f + sc.x) + sh.x, y1 = v[i].y * rinv * gg.y * (1.f + sc.y) + sh.y;
      float y2 = v[i].z * rinv * gg.z * (1.f + sc.z) + sh.z, y3 = v[i].w * rinv * gg.w * (1.f + sc.w) + sh.w;
      uint2 o; o.x = pack2(y0, y1); o.y = pack2(y2, y3);
      *(uint2*)(H + (size_t)row * 1024 + col) = o;
    }
  }
}

DI void phase_qknorm(const Params& p, int j, int wv) {
  const int tid = ltid(wv); const int lane = tid & 63, w = tid >> 6;
  const int tsel = lane >> 5, hh = (lane >> 1) & 15, axis = lane & 1;
  const int qk = 1;
  u16* QKB = (u16*)(p.ws + R_QKB);
  const float* gam = p.in[qk ? 25 : 24] + j * 64 + axis * 32;
  float gm[32];
#pragma unroll
  for (int d = 0; d < 32; ++d) gm[d] = gam[d];
  const float qscale = qk ? 1.f : 0.125f * 1.4426950408889634f;
  const int rstride = gridDim.x * 16;
  const int lcol = qk * 1024 + hh * 64 + axis * 32;
  uint4 nu[4];
  {
    const int row0 = (blockIdx.x * 8 + w) * 2 + tsel;
    if (row0 < NT) {
#pragma unroll
      for (int q = 0; q < 4; ++q) nu[q] = *(const uint4*)(QKB + (size_t)row0 * 2048 + lcol + q * 8);
    }
  }
  for (int row = (blockIdx.x * 8 + w) * 2 + tsel; row < NT; row += rstride) {
    u16* ptr = QKB + (size_t)row * 2048 + lcol;
    float v[32]; float ss = 0.f;
    uint4 cu[4];
#pragma unroll
    for (int q = 0; q < 4; ++q) cu[q] = nu[q];
    if (row + rstride < NT) {
#pragma unroll
      for (int q = 0; q < 4; ++q) nu[q] = *(const uint4*)(QKB + (size_t)(row + rstride) * 2048 + lcol + q * 8);
    }
#pragma unroll
    for (int q = 0; q < 4; ++q) {
      uint4 u = cu[q];
      v[q * 8 + 0] = bflo(u.x); v[q * 8 + 1] = bfhi(u.x); v[q * 8 + 2] = bflo(u.y); v[q * 8 + 3] = bfhi(u.y);
      v[q * 8 + 4] = bflo(u.z); v[q * 8 + 5] = bfhi(u.z); v[q * 8 + 6] = bflo(u.w); v[q * 8 + 7] = bfhi(u.w);
    }
#pragma unroll
    for (int d = 0; d < 32; ++d) ss += v[d] * v[d];
    ss += shx(ss, 1, lane);
    const float rinv = rsqrtf(ss * (1.f / 64.f) + 1e-6f);
#pragma unroll
    for (int d = 0; d < 32; ++d) v[d] = v[d] * rinv * gm[d];
    if (row < NX) {
      const int l = row & 2047;
      const float pos = (float)(axis ? (l & 63) : (l >> 6));
#pragma unroll
      for (int i2 = 0; i2 < 16; ++i2) {
        const float invf = exp2f(-(float)i2 * 0.8304820237218406f);
        const float ang = pos * invf;
        float sn, cs; __sincosf(ang, &sn, &cs);
        const float x1 = v[i2], x2 = v[16 + i2];
        v[i2] = x1 * cs - x2 * sn; v[16 + i2] = x1 * sn + x2 * cs;
      }
    }
#pragma unroll
    for (int q = 0; q < 4; ++q) {
      uint4 o;
      o.x = pack2(v[q * 8 + 0] * qscale, v[q * 8 + 1] * qscale); o.y = pack2(v[q * 8 + 2] * qscale, v[q * 8 + 3] * qscale);
      o.z = pack2(v[q * 8 + 4] * qscale, v[q * 8 + 5] * qscale); o.w = pack2(v[q * 8 + 6] * qscale, v[q * 8 + 7] * qscale);
      *(uint4*)(ptr + q * 8) = o;
    }
  }
}

#define MFMA32(a, b, c) __builtin_amdgcn_mfma_f32_32x32x16_bf16((a), (b), (c), 0, 0, 0)
DI void phase_attn(const Params& p, int j, float lam_init, bool last, unsigned char* shm, int wv, int slot) {
  const u16* QKB = (const u16*)(p.ws + R_QKB);
  const u16* VT = (const u16*)(p.ws + R_VT);
  u16* OB = (u16*)(p.ws + R_MIX);
  const int tid = ltid(wv), lane = tid & 63, w = tid >> 6;
  const int r = lane & 31, hh = lane >> 5, qsub = w >> 1, map = w & 1;
  float lam;
  {
    const float* lp = p.in[26] + j * 256;
    float a = lp[lane] * lp[64 + lane], b = lp[128 + lane] * lp[192 + lane];
    a = wave_sum(a, lane); b = wave_sum(b, lane);
    lam = __expf(a) - __expf(b) + lam_init;
  }
  bool fastsm;
  {
    float gq = fabsf(p.in[24][j * 64 + lane]), gk = fabsf(p.in[25][j * 64 + lane]);
#pragma unroll
    for (int o = 32; o >= 1; o >>= 1) { gq = fmaxf(gq, shx(gq, o, lane)); gk = fmaxf(gk, shx(gk, o, lane)); }
    const float bound = 11.6f * gq * gk;
    fastsm = __builtin_amdgcn_readfirstlane((int)(bound <= 100.f)) != 0;
  }
  const float* ghead = p.in[27] + j * 128;
  const int ntask = 4096 + (last ? 0 : 512);
  const int nb = gridDim.x;
  const int krow = tid >> 3, kch = tid & 7;
  if (wv >= 4) __builtin_amdgcn_s_setprio(1);
  for (int task = slot; task < ntask; task += nb) {
    int b, head, qrow0, kt0, nkt;
    if (task < 4096) { b = task >> 7; head = (task >> 4) & 7; qrow0 = b * 2048 + (task & 15) * 128; kt0 = 0; nkt = 36; }
    else { int t2 = task - 4096; b = t2 >> 4; head = (t2 >> 1) & 7; qrow0 = NX + b * 256 + (t2 & 1) * 128; kt0 = 32; nkt = 4; }
    const u16* vbase = VT + ((size_t)(b * 8 + head) * 128) * 2304;
    f32x16 O[4];
#pragma unroll
    for (int d = 0; d < 4; ++d)
#pragma unroll
      for (int i = 0; i < 16; ++i) O[d][i] = 0.f;
    float m_run = 0.f, l_run = 0.f;
    const int drow = w * 8 + (lane >> 3); const int dcg = (lane & 7) ^ ((drow >> 1) & 7);
    const u16* kptr = QKB + (size_t)((kt0 < 32) ? (b * 2048 + kt0 * 64 + drow) : (NX + b * 256 + (kt0 - 32) * 64 + drow)) * 2048 + 1024 + head * 128 + dcg * 8;
    const u16* vptr = vbase + (size_t)drow * 2304 + kt0 * 64 + dcg * 8;
    const u16* vptr2 = vptr + (size_t)64 * 2304;
    const unsigned ldsoff = w * 1024 + lane * 16;
    int dma_kt = kt0;
#define DMA_TILE(kt_, ks_, vs_) do { \
      unsigned char* kdst = shm + (ks_) * 16384 + ldsoff; \
      unsigned char* vdst = shm + 49152 + (vs_) * 16384 + ldsoff; \
      __builtin_amdgcn_global_load_lds((const unsigned*)kptr, (unsigned*)kdst, 16, 0, 0); \
      __builtin_amdgcn_global_load_lds((const unsigned*)(kptr + 64), (unsigned*)(kdst + 8192), 16, 0, 0); \
      __builtin_amdgcn_global_load_lds((const unsigned*)vptr, (unsigned*)vdst, 16, 0, 0); \
      __builtin_amdgcn_global_load_lds((const unsigned*)vptr2, (unsigned*)(vdst + 8192), 16, 0, 0); \
      ++dma_kt; vptr += 64; vptr2 += 64; \
      if (dma_kt == 32) kptr = QKB + (size_t)(NX + b * 256 + drow) * 2048 + 1024 + head * 128 + dcg * 8;     \
      else kptr += (size_t)64 * 2048; } while (0)
    const int swz = ((r >> 1) & 7);
#define QK_SOFTMAX(ks_, FAST_) do { \
      const unsigned char* kb_ = shm + (ks_) * 16384 + map * 8192; \
      f32x16 S[2]; \
      bf16x8 kf[2][4]; \
      _Pragma("unroll") for (int kb = 0; kb < 2; ++kb) _Pragma("unroll") for (int kk = 0; kk < 4; ++kk) \
        kf[kb][kk] = *(const bf16x8*)(kb_ + (kb * 32 + r) * 128 + (((kk * 2 + hh) ^ swz) << 4)); \
      _Pragma("unroll") for (int kb = 0; kb < 2; ++kb) _Pragma("unroll") for (int i = 0; i < 16; ++i) S[kb][i] = (FAST_) ? 0.f : -m_run; \
      __builtin_amdgcn_sched_barrier(0); \
      _Pragma("unroll") for (int kk = 0; kk < 4; ++kk) _Pragma("unroll") for (int kb = 0; kb < 2; ++kb) \
        S[kb] = MFMA32(kf[kb][kk], qf[kk], S[kb]); \
      __builtin_amdgcn_sched_barrier(0); \
      if (!(FAST_)) {   \
      float mx = S[0][0]; \
      _Pragma("unroll") for (int i = 1; i < 16; ++i) mx = fmaxf(mx, S[0][i]); \
      _Pragma("unroll") for (int i = 0; i < 16; ++i) mx = fmaxf(mx, S[1][i]); \
      mx = fmaxf(mx, shx(mx, 32, lane)); \
      const bool need = (it == 0) || (mx > 8.f); \
      if (__builtin_amdgcn_ballot_w64(need) != 0ull) { \
        const float delta = need ? mx : 0.f; \
        const float alpha = __builtin_amdgcn_exp2f(-delta); \
        m_run += delta; l_run *= alpha; \
        _Pragma("unroll") for (int d = 0; d < 4; ++d) _Pragma("unroll") for (int i = 0; i < 16; ++i) O[d][i] *= alpha; \
        _Pragma("unroll") for (int kb = 0; kb < 2; ++kb) _Pragma("unroll") for (int i = 0; i < 16; ++i) S[kb][i] -= delta; } } \
      float ps = 0.f; \
      _Pragma("unroll") for (int kb = 0; kb < 2; ++kb) _Pragma("unroll") for (int i = 0; i < 16; ++i) { float e_ = __builtin_amdgcn_exp2f(S[kb][i]); S[kb][i] = e_; ps += e_; } \
      l_run += ps; \
      _Pragma("unroll") for (int kb = 0; kb < 2; ++kb) _Pragma("unroll") for (int s2 = 0; s2 < 2; ++s2) _Pragma("unroll") for (int q4 = 0; q4 < 4; ++q4) \
        Pk[(kb * 2 + s2) * 4 + q4] = pack2(S[kb][8 * s2 + 2 * q4], S[kb][8 * s2 + 2 * q4 + 1]); } while (0)
#define PV(vs_) do { \
      const unsigned char* vb_ = shm + 49152 + (vs_) * 16384; \
      bf16x8 vf[4][4]; \
      _Pragma("unroll") for (int ks4 = 0; ks4 < 4; ++ks4) _Pragma("unroll") for (int d = 0; d < 4; ++d) \
        vf[ks4][d] = *(const bf16x8*)(vb_ + (d * 32 + r) * 128 + (((ks4 * 2 + hh) ^ swz) << 4)); \
      __builtin_amdgcn_sched_barrier(0); \
      _Pragma("unroll") for (int ks4 = 0; ks4 < 4; ++ks4) { \
        uint4 pu = make_uint4(Pk[ks4 * 4 + 0], Pk[ks4 * 4 + 1], Pk[ks4 * 4 + 2], Pk[ks4 * 4 + 3]); \
        bf16x8 pf = __builtin_bit_cast(bf16x8, pu); \
        _Pragma("unroll") for (int d = 0; d < 4; ++d) O[d] = MFMA32(vf[ks4][d], pf, O[d]); } \
      __builtin_amdgcn_sched_barrier(0); } while (0)
    unsigned Pk[16];
#pragma unroll
    for (int i = 0; i < 16; ++i) Pk[i] = 0u;
    DMA_TILE(kt0, 0, 0);
    if (1 < nkt) DMA_TILE(kt0 + 1, 1, 1);
    bf16x8 qf[4];
    {
      const int qtok = qrow0 + qsub * 32 + r;
      const u16* qp = QKB + (size_t)qtok * 2048 + head * 128 + map * 64 + hh * 8;
      float v[4][8]; float ss = 0.f;
#pragma unroll
      for (int kk = 0; kk < 4; ++kk) {
        uint4 u = *(const uint4*)(qp + kk * 16);
        v[kk][0] = bflo(u.x); v[kk][1] = bfhi(u.x); v[kk][2] = bflo(u.y); v[kk][3] = bfhi(u.y);
        v[kk][4] = bflo(u.z); v[kk][5] = bfhi(u.z); v[kk][6] = bflo(u.w); v[kk][7] = bfhi(u.w);
      }
#pragma unroll
      for (int kk = 0; kk < 4; ++kk)
#pragma unroll
        for (int jq = 0; jq < 8; ++jq) ss += v[kk][jq] * v[kk][jq];
      ss += shx(ss, 32, lane);
      const float rinv = rsqrtf(ss * (1.f / 64.f) + 1e-6f);
      const float* gq = p.in[24] + j * 64 + hh * 8;
#pragma unroll
      for (int kk = 0; kk < 4; ++kk) {
        float4 g0 = *(const float4*)(gq + kk * 16), g1 = *(const float4*)(gq + kk * 16 + 4);
        v[kk][0] *= rinv * g0.x; v[kk][1] *= rinv * g0.y; v[kk][2] *= rinv * g0.z; v[kk][3] *= rinv * g0.w;
        v[kk][4] *= rinv * g1.x; v[kk][5] *= rinv * g1.y; v[kk][6] *= rinv * g1.z; v[kk][7] *= rinv * g1.w;
      }
      if (task < 4096) {
        const int l = qtok & 2047;
        const float prow = (float)(l >> 6), pcol = (float)(l & 63);
#pragma unroll
        for (int jq = 0; jq < 8; ++jq) {
          const float invf = exp2f(-(float)(hh * 8 + jq) * 0.8304820237218406f);
          float sn, cs;
          __sincosf(prow * invf, &sn, &cs);
          { const float x1 = v[0][jq], x2 = v[1][jq]; v[0][jq] = x1 * cs - x2 * sn; v[1][jq] = x1 * sn + x2 * cs; }
          __sincosf(pcol * invf, &sn, &cs);
          { const float x1 = v[2][jq], x2 = v[3][jq]; v[2][jq] = x1 * cs - x2 * sn; v[3][jq] = x1 * sn + x2 * cs; }
        }
      }
      const float qs = 0.125f * 1.4426950408889634f;
#pragma unroll
      for (int kk = 0; kk < 4; ++kk) {
        uint4 o = make_uint4(pack2(v[kk][0] * qs, v[kk][1] * qs), pack2(v[kk][2] * qs, v[kk][3] * qs), pack2(v[kk][4] * qs, v[kk][5] * qs), pack2(v[kk][6] * qs, v[kk][7] * qs));
        qf[kk] = __builtin_bit_cast(bf16x8, o);
      }
    }
    if (1 < nkt) asm volatile("s_waitcnt vmcnt(4)" ::: "memory");
    else asm volatile("s_waitcnt vmcnt(0)" ::: "memory");
    __builtin_amdgcn_s_barrier();
    int ks = 0, vs = 0;
#define ATT_COMPUTE(FAST_) do { \
      if (map == 0) { QK_SOFTMAX(ks, FAST_); PV(vs); } \
      else { const int vsp = (vs + 3) & 3; if (it > 0) PV(vsp); QK_SOFTMAX(ks, FAST_); } } while (0)
#define ATT_LOOP(FAST_) \
    for (int it = 0; it < nkt; ++it) { \
      const int ks2 = (ks == 0) ? 2 : ks - 1; \
      if (it + 2 < nkt) DMA_TILE(kt0 + it + 2, ks2, (vs + 2) & 3); \
      ATT_COMPUTE(FAST_); \
      if (it + 2 < nkt) asm volatile("s_waitcnt vmcnt(4)" ::: "memory"); \
      else asm volatile("s_waitcnt vmcnt(0)" ::: "memory"); \
      __builtin_amdgcn_s_barrier(); \
      ks = (ks == 2) ? 0 : ks + 1; \
      vs = (vs + 1) & 3; \
    }
    if (fastsm) { ATT_LOOP(true) } else { ATT_LOOP(false) }
#undef ATT_LOOP
#undef ATT_COMPUTE
    if (map == 1) { const int vsp = (vs + 3) & 3; PV(vsp); }
    __syncthreads();
#undef DMA_TILE
#undef QK_SOFTMAX
#undef PV
    const float ltot = l_run + shx(l_run, 32, lane);
    const float inv = 1.f / ltot;
    float* X = (float*)shm;
    const int q = qsub * 32 + r;
    if (map == 1) {
#pragma unroll
      for (int d = 0; d < 4; ++d)
#pragma unroll
        for (int g4 = 0; g4 < 4; ++g4) {
          float4 o; o.x = O[d][g4 * 4 + 0] * inv; o.y = O[d][g4 * 4 + 1] * inv; o.z = O[d][g4 * 4 + 2] * inv; o.w = O[d][g4 * 4 + 3] * inv;
          *(float4*)(X + q * 132 + d * 32 + g4 * 8 + hh * 4) = o;
        }
    }
    __syncthreads();
    if (map == 0) {
      float ss = 0.f;
#pragma unroll
      for (int d = 0; d < 4; ++d)
#pragma unroll
        for (int g4 = 0; g4 < 4; ++g4) {
          float4 x2 = *(const float4*)(X + q * 132 + d * 32 + g4 * 8 + hh * 4);
          float o0 = O[d][g4 * 4 + 0] * inv - lam * x2.x, o1 = O[d][g4 * 4 + 1] * inv - lam * x2.y;
          float o2 = O[d][g4 * 4 + 2] * inv - lam * x2.z, o3 = O[d][g4 * 4 + 3] * inv - lam * x2.w;
          O[d][g4 * 4 + 0] = o0; O[d][g4 * 4 + 1] = o1; O[d][g4 * 4 + 2] = o2; O[d][g4 * 4 + 3] = o3;
          ss += o0 * o0 + o1 * o1 + o2 * o2 + o3 * o3;
        }
      ss += shx(ss, 32, lane);
      const float rinv = rsqrtf(ss * (1.f / 128.f) + 1e-6f) * (1.f - lam_init);
      unsigned char* os = shm + 67584 + q * 272;
#pragma unroll
      for (int d = 0; d < 4; ++d)
#pragma unroll
        for (int g4 = 0; g4 < 4; ++g4) {
          const int dv = d * 32 + g4 * 8 + hh * 4;
          float4 gh = *(const float4*)(ghead + dv);
          uint2 o; o.x = pack2(O[d][g4 * 4 + 0] * rinv * gh.x, O[d][g4 * 4 + 1] * rinv * gh.y);
          o.y = pack2(O[d][g4 * 4 + 2] * rinv * gh.z, O[d][g4 * 4 + 3] * rinv * gh.w);
          *(uint2*)(os + dv * 2) = o;
        }
    }
    asm volatile("s_waitcnt lgkmcnt(0)" ::: "memory");
    __builtin_amdgcn_s_barrier();
    {
      u16* ob = OB + (size_t)qrow0 * 1024 + head * 128;
#pragma unroll
      for (int i = 0; i < 4; ++i) {
        const int c = tid + 512 * i, row = c >> 4, c16 = c & 15;
        const uint4 v = *(const uint4*)(shm + 67584 + row * 272 + c16 * 16);
        *(uint4*)(ob + (size_t)row * 1024 + c16 * 8) = v;
      }
    }
    asm volatile("s_waitcnt lgkmcnt(0)" ::: "memory");
    __builtin_amdgcn_s_barrier();
  }
  __builtin_amdgcn_s_setprio(0);
}

DI float gelu_tanh(float y) {
  const float z = 0.7978845608028654f * (y + 0.044715f * y * y * y);
  const float t = 1.f - 2.f / (__expf(2.f * z) + 1.f);
  return 0.5f * y * (1.f + t);
}
DI int ssm_tok(int d, int b, int tau) {
  if (d == 0) return tau < 256 ? (NX + b * 256 + tau) : (b * 2048 + tau - 256);
  return tau < 256 ? (NX + b * 256 + 255 - tau) : (b * 2048 + 2047 - (tau - 256));
}
DI void phase_scan(const Params& p, int j, unsigned char* shm, int wv) {
  const int tid = ltid(wv), lane = tid & 63, w = tid >> 6;
  unsigned char* wl = shm + w * 12800;
  float* bu = (float*)wl;
  u16* Hl = (u16*)(wl + 8448);
  u16* BbT = (u16*)wl;
  const u16* ZS = (const u16*)(p.ws + R_ZS);
  const int col = lane & 15, quad = lane >> 4;
  for (int wg = blockIdx.x; wg < 256; wg += gridDim.x) {
    const int wt = wg * 8 + w;
    const int d = wt & 1, g = (wt >> 1) & 31, b = wt >> 6;
    const int dg = (j * 2 + d) * 32 + g;
    const int pst = lane;
    float abr, abi;
    {
      const float are = p.in[12][dg * 64 + pst], aim = p.in[13][dg * 64 + pst];
      const float dt = expf(p.in[14][dg]);
      const float er = expf(are * dt), ang = aim * dt;
      abr = er * cosf(ang); abi = er * sinf(ang);
      const float nr = abr - 1.f, ni = abi, den = are * are + aim * aim;
      const float cr = (nr * are + ni * aim) / den, ci = (ni * are - nr * aim) / den;
      const float* bre = p.in[15] + ((size_t)dg * 64 + pst) * 16;
      const float* bim = p.in[16] + ((size_t)dg * 64 + pst) * 16;
      __builtin_amdgcn_wave_barrier();
#pragma unroll
      for (int h = 0; h < 16; h += 2) {
        float br0 = bre[h], bi0 = bim[h], br1 = bre[h + 1], bi1 = bim[h + 1];
        *(unsigned*)(BbT + (2 * pst) * 16 + h) = pack2(cr * br0 - ci * bi0, cr * br1 - ci * bi1);
        *(unsigned*)(BbT + (2 * pst + 1) * 16 + h) = pack2(cr * bi0 + ci * br0, cr * bi1 + ci * br1);
      }
      __builtin_amdgcn_wave_barrier();
    }
    s16x4 bop[8];
#pragma unroll
    for (int nb = 0; nb < 8; ++nb) bop[nb] = *(const s16x4*)(BbT + (nb * 16 + col) * 16 + quad * 4);
    bf16x8 cop[4];
    {
      const float* cre = p.in[17] + ((size_t)dg * 16 + col) * 64;
      const float* cim = p.in[18] + ((size_t)dg * 16 + col) * 64;
#pragma unroll
      for (int kb = 0; kb < 4; ++kb) {
        float4 a = *(const float4*)(cre + kb * 16 + quad * 4), c = *(const float4*)(cim + kb * 16 + quad * 4);
        uint4 u = make_uint4(pack2(a.x, -c.x), pack2(a.y, -c.y), pack2(a.z, -c.z), pack2(a.w, -c.w));
        cop[kb] = __builtin_bit_cast(bf16x8, u);
      }
    }
    __builtin_amdgcn_wave_barrier();
    u16* Rd = (u16*)(p.ws + (d ? R_R1 : R_R0));
    float hr = 0.f, hi = 0.f;
    s16x4 ua = *(const s16x4*)(ZS + (size_t)ssm_tok(d, b, col) * 512 + g * 16 + quad * 4);
    s16x4 ub = *(const s16x4*)(ZS + (size_t)ssm_tok(d, b, 16 + col) * 512 + g * 16 + quad * 4);
    for (int c = 0; c < 144; ++c) {
      const int tau0 = c * 16;
      s16x4 ucur = ua;
      ua = ub;
      if (c + 2 < 144) ub = *(const s16x4*)(ZS + (size_t)ssm_tok(d, b, tau0 + 32 + col) * 512 + g * 16 + quad * 4);
#pragma unroll
      for (int nb = 0; nb < 8; ++nb) {
        f32x4 z = {0.f, 0.f, 0.f, 0.f};
        f32x4 r4 = __builtin_amdgcn_mfma_f32_16x16x16bf16_1k(ucur, bop[nb], z, 0, 0, 0);
#pragma unroll
        for (int jj = 0; jj < 4; ++jj) bu[(quad * 4 + jj) * 132 + nb * 16 + col] = r4[jj];
      }
      __builtin_amdgcn_wave_barrier();
      float2 bv[16];
#pragma unroll
      for (int t = 0; t < 16; ++t) bv[t] = *(const float2*)(bu + t * 132 + 2 * pst);
#pragma unroll
      for (int t = 0; t < 16; ++t) {
        const float nr = abr * hr - abi * hi + bv[t].x;
        const float ni = abr * hi + abi * hr + bv[t].y;
        hr = nr; hi = ni;
        *(unsigned*)(Hl + t * 136 + 2 * pst) = pack2(hr, hi);
      }
      __builtin_amdgcn_wave_barrier();
      f32x4 y = {0.f, 0.f, 0.f, 0.f};
#pragma unroll
      for (int kb = 0; kb < 4; ++kb) {
        bf16x8 af = *(const bf16x8*)(Hl + col * 136 + kb * 32 + quad * 8);
        y = __builtin_amdgcn_mfma_f32_16x16x32_bf16(cop[kb], af, y, 0, 0, 0);
      }
      {
        const int tok = ssm_tok(d, b, tau0 + col);
        uint2 o; o.x = pack2(y[0], y[1]); o.y = pack2(y[2], y[3]);
        *(uint2*)(Rd + (size_t)tok * 512 + g * 16 + quad * 4) = o;
      }
      __builtin_amdgcn_wave_barrier();
    }
    __syncthreads();
    __builtin_amdgcn_fence(__ATOMIC_ACQUIRE, "agent");
    {
      const u16* R0 = (const u16*)(p.ws + R_R0);
      const u16* R1 = (const u16*)(p.ws + R_R1);
      u16* YS = (u16*)(p.ws + R_YS);
      const int bb = wg >> 3, c0 = (wg & 7) * 64;
      const int c8 = c0 + (tid & 7) * 8;
      const float* dsk = p.in[19] + j * 512 + c8;
      const float4 d0 = *(const float4*)dsk, d1 = *(const float4*)(dsk + 4);
      for (int t0 = tid >> 3; t0 < 2304; t0 += 256) {
        uint4 u[4], a[4], bq[4]; size_t off[4];
#pragma unroll
        for (int q = 0; q < 4; ++q) {
          const int t = t0 + 64 * q;
          const int tok = (t < 2048) ? (bb * 2048 + t) : (NX + bb * 256 + (t - 2048));
          off[q] = (size_t)tok * 512 + c8;
          u[q] = *(const uint4*)(ZS + off[q]); a[q] = *(const uint4*)(R0 + off[q]); bq[q] = *(const uint4*)(R1 + off[q]);
        }
#pragma unroll
        for (int q = 0; q < 4; ++q) {
          float y0 = gelu_tanh(bflo(u[q].x) * d0.x + bflo(a[q].x) + bflo(bq[q].x)), y1 = gelu_tanh(bfhi(u[q].x) * d0.y + bfhi(a[q].x) + bfhi(bq[q].x));
          float y2 = gelu_tanh(bflo(u[q].y) * d0.z + bflo(a[q].y) + bflo(bq[q].y)), y3 = gelu_tanh(bfhi(u[q].y) * d0.w + bfhi(a[q].y) + bfhi(bq[q].y));
          float y4 = gelu_tanh(bflo(u[q].z) * d1.x + bflo(a[q].z) + bflo(bq[q].z)), y5 = gelu_tanh(bfhi(u[q].z) * d1.y + bfhi(a[q].z) + bfhi(bq[q].z));
          float y6 = gelu_tanh(bflo(u[q].w) * d1.z + bflo(a[q].w) + bflo(bq[q].w)), y7 = gelu_tanh(bfhi(u[q].w) * d1.w + bfhi(a[q].w) + bfhi(bq[q].w));
          uint4 o; o.x = pack2(y0, y1); o.y = pack2(y2, y3); o.z = pack2(y4, y5); o.w = pack2(y6, y7);
          *(uint4*)(YS + off[q]) = o;
        }
      }
    }
    __syncthreads();
  }
}

DI void phase_combine(const Params& p, int j, int wv) {
  const u16* ZS = (const u16*)(p.ws + R_ZS);
  const u16* R0 = (const u16*)(p.ws + R_R0);
  const u16* R1 = (const u16*)(p.ws + R_R1);
  u16* YS = (u16*)(p.ws + R_YS);
  const float* dsk = p.in[19] + j * 512;
  const int gt = blockIdx.x * 512 + ltid(wv), nth = gridDim.x * 512;
  for (int idx = gt; idx < NT * 64; idx += nth) {
    const int c8 = (idx & 63) * 8;
    const size_t off = (size_t)idx * 8;
    uint4 u = *(const uint4*)(ZS + off), a = *(const uint4*)(R0 + off), b = *(const uint4*)(R1 + off);
    float4 d0 = *(const float4*)(dsk + c8), d1 = *(const float4*)(dsk + c8 + 4);
    float y0 = gelu_tanh(bflo(u.x) * d0.x + bflo(a.x) + bflo(b.x)), y1 = gelu_tanh(bfhi(u.x) * d0.y + bfhi(a.x) + bfhi(b.x));
    float y2 = gelu_tanh(bflo(u.y) * d0.z + bflo(a.y) + bflo(b.y)), y3 = gelu_tanh(bfhi(u.y) * d0.w + bfhi(a.y) + bfhi(b.y));
    float y4 = gelu_tanh(bflo(u.z) * d1.x + bflo(a.z) + bflo(b.z)), y5 = gelu_tanh(bfhi(u.z) * d1.y + bfhi(a.z) + bfhi(b.z));
    float y6 = gelu_tanh(bflo(u.w) * d1.z + bflo(a.w) + bflo(b.w)), y7 = gelu_tanh(bfhi(u.w) * d1.w + bfhi(a.w) + bfhi(b.w));
    uint4 o; o.x = pack2(y0, y1); o.y = pack2(y2, y3); o.z = pack2(y4, y5); o.w = pack2(y6, y7);
    *(uint4*)(YS + off) = o;
  }
}

#define XB_TMO      128
#define XB_XCNT(j)  (256  + 64 * (j))
#define XB_XSUB(j)  (1280 + 64 * (j))
#define XB_XGEN(j)  (2304 + 64 * (j))
#define XB_TOP      3328
#define XB_TOPGEN   3392
#define XCD_BAR_WORDS 3456
#define XB_SPIN_CAP (1u << 18)
#define LAS __attribute__((address_space(3)))
__device__ __forceinline__ unsigned xb_ld(unsigned* p)              { return __hip_atomic_load(p, __ATOMIC_RELAXED, __HIP_MEMORY_SCOPE_AGENT); }
__device__ __forceinline__ unsigned xb_add(unsigned* p, unsigned v) { return __hip_atomic_fetch_add(p, v, __ATOMIC_RELAXED, __HIP_MEMORY_SCOPE_AGENT); }
__device__ __forceinline__ unsigned xb_xcc_id() { return (unsigned)__builtin_amdgcn_s_getreg((3 << 11) | 20) & 0xFu; }
#define XB_SPIN(cond, bar) do { unsigned _sp = 0; while (cond) { __builtin_amdgcn_s_sleep(1); \
    if ((++_sp & 255u) == 0u) { if (xb_ld(&(bar)[XB_TMO])) break; if (_sp > XB_SPIN_CAP) { atomicAdd(&(bar)[XB_TMO], 1u); break; } } } } while (0)
struct XcdBarrier { unsigned* bar; unsigned x; volatile LAS unsigned* st; };
__device__ __forceinline__ XcdBarrier xcd_barrier_post(unsigned* bar, volatile LAS unsigned* st) {
    XcdBarrier b; b.bar = bar; b.x = xb_xcc_id(); b.st = st;
    if (threadIdx.x == 0) (void)xb_add(&bar[XB_XCNT(b.x)], 1u);
    return b;
}
__device__ __forceinline__ void xcd_barrier_complete(unsigned* bar, unsigned x, unsigned& nloc, unsigned& nx) {
    const unsigned G = gridDim.x * gridDim.y * gridDim.z;
    unsigned sum, cnt, mine, sp = 0u;
    for (;;) {
        sum = 0u; cnt = 0u; mine = 0u;
#pragma unroll
        for (unsigned j = 0; j < 16; ++j) { const unsigned c = xb_ld(&bar[XB_XCNT(j)]); sum += c; cnt += (c > 0u) ? 1u : 0u; mine = (j == x) ? c : mine; }
        if (sum == G) break;
        __builtin_amdgcn_s_sleep(1);
        if ((++sp & 255u) == 0u) { if (xb_ld(&bar[XB_TMO])) break; if (sp > XB_SPIN_CAP) { atomicAdd(&bar[XB_TMO], 1u); break; } }
    }
    nloc = mine > 0u ? mine : 1u; nx = cnt > 0u ? cnt : 1u;
}
__device__ __forceinline__ void xcd_barrier(const XcdBarrier& b, int wv) {
    asm volatile("s_waitcnt vmcnt(0)" ::: "memory");
    __syncthreads();
    if (ltid(wv) == 0) {
        unsigned* bar = b.bar;
        unsigned bx = b.x; asm volatile("" : "+s"(bx));
        __builtin_amdgcn_s_waitcnt(0);
        unsigned nloc = b.st[0], nx = b.st[1];
        if (nloc == 0u) { xcd_barrier_complete(bar, bx, nloc, nx); b.st[0] = nloc; b.st[1] = nx; }
        const unsigned old = xb_add(&bar[XB_XSUB(bx)], 1u);
        const unsigned gen = old / nloc;
        if (old + 1u == (gen + 1u) * nloc) {
            __builtin_amdgcn_fence(__ATOMIC_RELEASE, "agent");
            asm volatile("s_waitcnt vmcnt(0)" ::: "memory");
            const unsigned og = xb_add(&bar[XB_TOP], 1u);
            const unsigned tg = og / nx;
            if (og + 1u == (tg + 1u) * nx) xb_add(&bar[XB_TOPGEN], 1u);
            else XB_SPIN(xb_ld(&bar[XB_TOPGEN]) == tg, bar);
            __builtin_amdgcn_fence(__ATOMIC_ACQUIRE, "agent");
            xb_add(&bar[XB_XGEN(bx)], 1u);
            asm volatile("s_waitcnt vmcnt(0)" ::: "memory");
        } else {
            XB_SPIN(xb_ld(&bar[XB_XGEN(bx)]) == gen, bar);
            __builtin_amdgcn_fence(__ATOMIC_ACQUIRE, "agent");
            asm volatile("s_waitcnt vmcnt(0)" ::: "memory");
        }
    }
    __syncthreads();
}

__global__ void __launch_bounds__(512) mega(Params p) {
  extern __shared__ __attribute__((aligned(16))) unsigned char shm[];
  cg::grid_group grid = cg::this_grid();
  unsigned char* ws = p.ws;
  u16* H = (u16*)(ws + OFF_H);
  float* CTXR = (float*)(ws + OFF_CTXR);
  const float* modv = (const float*)(ws + OFF_MODV);

  __shared__ uint4 xb_words;
  if (threadIdx.x == 0) xb_words = make_uint4(0u, 0u, 0u, 0u);
  __syncthreads();
  XcdBarrier xb; xb.bar = (unsigned*)(ws + OFF_BAR); xb.x = xb_xcc_id(); xb.st = (volatile LAS unsigned*)&xb_words;
  if (blockIdx.x == 0) { for (int i = threadIdx.x; i < XCD_BAR_WORDS; i += 512) xb.bar[i] = 0u; }
  const int wv = __builtin_amdgcn_readfirstlane((int)(threadIdx.x >> 6));
  phase_prep(p, shm, wv);
  grid.sync();
  if (threadIdx.x == 0) xb_words.w = xb_add(&xb.bar[XB_XCNT(xb.x)], 1u);

  phase_sh(p, wv);
  phase_norm(p, 0, 1, p.in[0], p.in[2], NT, wv);
  xcd_barrier(xb, wv);
  if (threadIdx.x == 0) {
    unsigned base = 0;
    for (unsigned jx = 0; jx < 16; ++jx) { const unsigned c = xb_ld(&xb.bar[XB_XCNT(jx)]); base += (jx < xb.x) ? c : 0u; }
    xb_words.z = base + xb_words.w;
  }
  __syncthreads();
  const int slot = __builtin_amdgcn_readfirstlane((int)xb_words.z);
  const float* STATS = (const float*)(ws + OFF_STATS);
  const float* SHW = (const float*)(ws + OFF_SHW);

  for (int i = 0; i < 4; ++i) {
    const bool last = (i == 3);
    const int j = i >> 1;
    const float* xsrc = (i == 0) ? p.in[0] : p.out;
    const float* csrc = (i == 0) ? p.in[2] : CTXR;
    const float* st1 = (i == 0) ? nullptr : STATS;
    const float* shw1 = SHW + (size_t)(i * 2) * 33 * 4096;
    Epi e{};
    if ((i & 1) == 0) {
      e = Epi{}; e.o16 = (u16*)(ws + R_ABT); e.o16b = (u16*)(ws + R_ABTC); e.stats = st1; e.shw = shw1;
      gemm_phase<EPI_FT>((const u16*)(ws + OFF_EVIN) + (size_t)j * 1536 * 1024, 1024, H, 1024, 1024, NT, 1024, e, shm, wv, slot);
      e = Epi{}; e.o16 = (u16*)(ws + R_ZS); e.ldo = 512; e.stats = st1; e.shw = shw1 + 1024;
      gemm_phase<EPI_STORE>(H, 1024, (const u16*)(ws + OFF_EVIN) + (size_t)j * 1536 * 1024 + 1024 * 1024, 1024, NT, 512, 1024, e, shm, wv, (int)gridDim.x - 1 - slot);
      xcd_barrier(xb, wv);
      e = Epi{}; e.o16 = (u16*)(ws + R_MIX); e.rowbase = 0; e.L = 2048;
      gemm_phase<EPI_FOUT>((const u16*)(ws + OFF_F2048), 4096, (const u16*)(ws + R_ABT), 4096, 2048, 16384, 4096, e, shm, wv, slot);
      e = Epi{}; e.o16 = (u16*)(ws + R_MIX); e.rowbase = NX; e.L = 256;
      gemm_phase<EPI_FOUT>((const u16*)(ws + OFF_F256), 512, (const u16*)(ws + R_ABTC), 512, 256, 16384, 512, e, shm, wv, slot);
      __syncthreads();
      phase_scan(p, j, shm, wv);
      xcd_barrier(xb, wv);
      e = Epi{}; e.o16 = (u16*)(ws + R_MIX); e.a16 = (const u16*)(ws + R_YS); e.bias = p.in[21] + j * 512;
      gemm_phase<EPI_GLU>((const u16*)(ws + R_YS), 512, (const u16*)(ws + OFF_GLU) + (size_t)j * 512 * 512, 512, NT, 512, 512, e, shm, wv, slot);
      if (i == 0) {
      {
        const int nbk = (int)gridDim.x;
        int off = 0;
        for (int q = 0; q < 8; ++q) {
          const int li = q >> 1, lj = li >> 1;
          Epi es{}; es.xo = (float*)(ws + OFF_SHW) + (size_t)q * 33 * 4096;
          const u16* Aq = (const u16*)(ws + OFF_SH) + (size_t)q * 256 * 1024;
          const u16* Bq; int Nq;
          if (q & 1) { Bq = (const u16*)(ws + OFF_W1T) + (size_t)li * 4096 * 1024; Nq = 4096; }
          else if ((li & 1) == 0) { Bq = (const u16*)(ws + OFF_EVIN) + (size_t)lj * 1536 * 1024; Nq = 1536; }
          else { Bq = (const u16*)(ws + OFF_ODIN) + (size_t)lj * 3072 * 1024; Nq = 3072; }
          const int sl = (slot + nbk - ((off + 64) % nbk)) % nbk;
          gemm_phase<EPI_F32>(Aq, 1024, Bq, 1024, 256, Nq, 1024, es, shm, wv, sl);
          off += Nq / 256;
        }
      }
      }
      xcd_barrier(xb, wv);
      e = Epi{}; e.xo = p.out; e.co = CTXR; e.xi = xsrc; e.ci = csrc; e.gate = modv + (size_t)i * 33 * 6144 + 2 * 1024;
      e.hout = H; e.stats_out = (float*)(ws + OFF_STATS); e.ngain = p.in[5] + i * 1024; e.nscale = modv + (size_t)i * 33 * 6144 + 4 * 1024;
      gemm_phase<EPI_RESID>((const u16*)(ws + R_MIX), 1024, (const u16*)(ws + OFF_EVOUT) + (size_t)j * 1024 * 1024, 1024, NT, 1024, 1024, e, shm, wv, slot);
    } else {
      e = Epi{}; e.o16 = (u16*)(ws + R_QKB); e.ldo = 2048; e.stats = st1; e.shw = shw1;
      gemm_phase<EPI_STORE>(H, 1024, (const u16*)(ws + OFF_ODIN) + (size_t)j * 3072 * 1024, 1024, NT, 2048, 1024, e, shm, wv, slot);
      xcd_barrier(xb, wv);
      e = Epi{}; e.o16 = (u16*)(ws + R_VT); e.stats = st1; e.shw = shw1 + 2048;
      if (slot & 1) phase_qknorm(p, j, wv);
      gemm_phase<EPI_VT>((const u16*)(ws + OFF_ODIN) + (size_t)j * 3072 * 1024 + (size_t)2048 * 1024, 1024, H, 1024, 1024, NT, 1024, e, shm, wv, (int)gridDim.x - 1 - slot);
      if (!(slot & 1)) { __syncthreads(); phase_qknorm(p, j, wv); }
      xcd_barrier(xb, wv);
      const float lam_init = 0.8f - 0.6f * expf(-0.3f * (float)i);
      phase_attn(p, j, lam_init, last, shm, wv, slot);
      xcd_barrier(xb, wv);
      e = Epi{}; e.xo = p.out; e.co = CTXR; e.xi = xsrc; e.ci = csrc; e.gate = modv + (size_t)i * 33 * 6144 + 2 * 1024;
      e.hout = H; e.stats_out = (float*)(ws + OFF_STATS); e.ngain = p.in[5] + i * 1024; e.nscale = modv + (size_t)i * 33 * 6144 + 4 * 1024;
      gemm_phase<EPI_RESID>((const u16*)(ws + R_MIX), 1024, (const u16*)(ws + OFF_ODOUT) + (size_t)j * 1024 * 1024, 1024, last ? NX : NT, 1024, 1024, e, shm, wv, slot);
    }
    xcd_barrier(xb, wv);
    const int nrows = last ? NX : NT;
    e = Epi{}; e.o16 = (u16*)(ws + R_HID); e.ldo = 4096; e.stats = STATS; e.shw = SHW + (size_t)(i * 2 + 1) * 33 * 4096;
    gemm_phase<EPI_SQRELU>(H, 1024, (const u16*)(ws + OFF_W1T) + (size_t)i * 4096 * 1024, 1024, nrows, 4096, 1024, e, shm, wv, slot);
    xcd_barrier(xb, wv);
    e = Epi{}; e.xo = p.out; e.co = CTXR; e.xi = p.out; e.ci = CTXR; e.gate = modv + (size_t)i * 33 * 6144 + 5 * 1024;
    if (!last) { e.hout = H; e.stats_out = (float*)(ws + OFF_STATS); e.ngain = p.in[4] + (i + 1) * 1024; e.nscale = modv + (size_t)(i + 1) * 33 * 6144 + 1 * 1024; }
    gemm_phase<EPI_RESID>((const u16*)(ws + R_HID), 4096, (const u16*)(ws + OFF_W2T) + (size_t)i * 4096 * 1024, 4096, nrows, 1024, 4096, e, shm, wv, slot);
    xcd_barrier(xb, wv);
  }
}

extern "C" void kernel_launch(void* const* d_in, const int* in_sizes, int n_in,
                              void* d_out, int out_size, void* d_ws, size_t ws_size,
                              hipStream_t stream) {
  static int grid_blocks = 0;
  if (!grid_blocks) {
    int dev = 0, cus = 0, per_cu = 0;
    (void)hipGetDevice(&dev);
    (void)hipDeviceGetAttribute(&cus, hipDeviceAttributeMultiprocessorCount, dev);
    (void)hipFuncSetAttribute((const void*)mega, hipFuncAttributeMaxDynamicSharedMemorySize, LDS_BYTES);
    (void)hipOccupancyMaxActiveBlocksPerMultiprocessor(&per_cu, (const void*)mega, 512, LDS_BYTES);
    if (per_cu < 1) per_cu = 1;
    grid_blocks = cus * per_cu;
    if (n_in != 28 || ws_size < WS_END) { fprintf(stderr, "kernel_launch: bad shapes n_in=%d ws=%zu\n", n_in, ws_size); grid_blocks = -1; }
  }
  if (grid_blocks < 0) return;
  Params p{};
  for (int i = 0; i < 28; ++i) p.in[i] = (const float*)d_in[i];
  p.out = (float*)d_out;
  p.ws = (unsigned char*)d_ws;
  void* args[] = {&p};
  hipError_t e = hipLaunchCooperativeKernel((void*)mega, dim3(grid_blocks), dim3(512), args, LDS_BYTES, stream);
  if (e != hipSuccess) fprintf(stderr, "cooperative launch failed: %s\n", hipGetErrorString(e));
}
```
